# Optimizing an MI355X kernel written in HIP

```python
import math
import jax, jax.numpy as jnp
from jax import lax
import numpy as np

D_MODEL = 1024
BATCH = 4
SEQ = 8192
DEPTH = 2

CHUNK = 64
Q_BLOCK = 128
LN_EPS = 1e-5
SB_HEADS = 8
SB_HEAD_DIM = 64
SB_WIDTH = SB_HEADS * SB_HEAD_DIM
RET_HEADS = 4
RET_HEAD_DIM = 128
RET_WIDTH = RET_HEADS * RET_HEAD_DIM
EVEN_IN = 3 * SB_WIDTH + 4 * RET_WIDTH
EVEN_MIX = SB_WIDTH + RET_WIDTH
DIFF_HEADS = 8
DIFF_HEAD_DIM = 64
DIFF_V_DIM = 2 * DIFF_HEAD_DIM
DIFF_QK = DIFF_HEADS * 2 * DIFF_HEAD_DIM
DIFF_VW = DIFF_HEADS * DIFF_V_DIM
ODD_IN = 2 * DIFF_QK + DIFF_VW
N_GROUPS = 4
EXPERTS_PER_GROUP = 8
N_EXPERTS = N_GROUPS * EXPERTS_PER_GROUP
TOP_K = 2
EXPERT_FF = 512
MOE_BLOCK = 128
N_EVEN = (DEPTH + 1) // 2
N_ODD = DEPTH // 2

kernel_name = 'hybrid_sb_retention_diffattn_hmoe'


def layer_norm(x, g, b):
    xf = x.astype(jnp.float32)
    mu = jnp.mean(xf, axis=-1, keepdims=True)
    var = jnp.mean(jnp.square(xf - mu), axis=-1, keepdims=True)
    y = (xf - mu) * lax.rsqrt(var + LN_EPS) * g.astype(jnp.float32) + b.astype(jnp.float32)
    return y.astype(x.dtype)


def split_cols(a, sizes):
    out = []
    o = 0
    for s in sizes:
        out.append(a[..., o:o + s])
        o += s
    return out


def stick_breaking_attention(q, k, v):
    B, S, H, dh = q.shape
    nb = S // Q_BLOCK
    kh = k.transpose(0, 2, 1, 3)
    vh = v.transpose(0, 2, 1, 3)
    q_blocks = jnp.moveaxis(q.transpose(0, 2, 1, 3).reshape(B, H, nb, Q_BLOCK, dh), 2, 0)
    key_pos = jnp.arange(S)
    scale = dh ** -0.5

    def block(args):
        qb, start = args
        z = jnp.einsum('bhqd,bhkd->bhqk', qb, kh, preferred_element_type=jnp.float32) * scale
        q_pos = start + jnp.arange(Q_BLOCK)
        mask = key_pos[None, :] < q_pos[:, None]
        log_1m_beta = jnp.where(mask, jax.nn.log_sigmoid(-z), 0.0)
        between = lax.cumsum(log_1m_beta, axis=3, reverse=True) - log_1m_beta
        w = jnp.where(mask, jnp.exp(jax.nn.log_sigmoid(z) + between), 0.0)
        return jnp.einsum('bhqk,bhkd->bhqd', w.astype(vh.dtype), vh)

    out = lax.map(block, (q_blocks, jnp.arange(nb) * Q_BLOCK))
    return jnp.moveaxis(out, 0, 2).reshape(B, H, S, dh).transpose(0, 2, 1, 3).reshape(B, S, H * dh)


def retention(q, k, v, g, gn_gain):
    B, S, H, d = q.shape
    nc = S // CHUNK
    f32 = jnp.float32

    def chunked(t):
        return t.astype(f32).transpose(0, 2, 1, 3).reshape(B, H, nc, CHUNK, d)

    qc = chunked(q)
    kc = chunked(k) * (d ** -0.5)
    vc = chunked(v)
    log_gamma = jnp.log1p(-jnp.exp2(-5.0 - jnp.arange(H, dtype=f32)))
    pos = jnp.arange(CHUNK, dtype=f32)
    intra_decay = jnp.exp(log_gamma[:, None, None] * jnp.abs(pos[:, None] - pos[None, :]))
    scores = jnp.einsum('bhncd,bhnsd->bhncs', qc, kc) * intra_decay[None, :, None]
    intra = jnp.einsum('bhncs,bhnse->bhnce', scores, vc)
    k_decay = jnp.exp(log_gamma[:, None] * (CHUNK - 1 - pos)[None, :])
    q_decay = jnp.exp(log_gamma[:, None] * (pos + 1.0)[None, :])
    chunk_kv = jnp.einsum('bhnsd,bhnse->nbhde', kc * k_decay[None, :, None, :, None], vc)
    chunk_decay = jnp.exp(log_gamma * CHUNK)[None, :, None, None]

    def step(state, kv):
        return chunk_decay * state + kv, state

    _, prev_state = lax.scan(step, jnp.zeros((B, H, d, d), f32), chunk_kv)
    inter = jnp.einsum('bhncd,nbhde->bhnce', qc * q_decay[None, :, None, :, None], prev_state)
    o = (intra + inter).reshape(B, H, S, d)
    mu = jnp.mean(o, axis=-1, keepdims=True)
    var = jnp.mean(jnp.square(o - mu), axis=-1, keepdims=True)
    o = ((o - mu) * lax.rsqrt(var + LN_EPS)).transpose(0, 2, 1, 3).reshape(B, S, H * d)
    o = o * gn_gain.astype(f32) * jax.nn.silu(g.astype(f32).reshape(B, S, H * d))
    return o.astype(q.dtype)


def differential_attention(q, k, v, lam, lambda_init, subln_gain):
    B, S, H, _, dh = q.shape
    dv = v.shape[-1]
    nb = S // Q_BLOCK
    f32 = jnp.float32
    kh = k.transpose(0, 2, 3, 1, 4)
    vh = v.transpose(0, 2, 1, 3)
    q_blocks = jnp.moveaxis(q.transpose(0, 2, 3, 1, 4).reshape(B, H, 2, nb, Q_BLOCK, dh), 3, 0)
    slopes = jnp.exp2(-8.0 / H * (jnp.arange(H, dtype=f32) + 1.0))
    key_pos = jnp.arange(S)
    key_chunk = key_pos // CHUNK
    scale = dh ** -0.5

    def block(args):
        qb, start = args
        z = jnp.einsum('bhmqd,bhmkd->bhmqk', qb, kh, preferred_element_type=f32) * scale
        q_pos = start + jnp.arange(Q_BLOCK)
        dist = jnp.abs(q_pos[:, None] - key_pos[None, :]).astype(f32)
        z = z - slopes[:, None, None, None] * dist
        mask = key_chunk[None, :] <= (q_pos // CHUNK)[:, None]
        p = jax.nn.softmax(jnp.where(mask, z, -jnp.inf), axis=-1)
        a = p[:, :, 0] - lam * p[:, :, 1]
        return jnp.einsum('bhqk,bhkd->bhqd', a.astype(vh.dtype), vh)

    out = lax.map(block, (q_blocks, jnp.arange(nb) * Q_BLOCK))
    o = jnp.moveaxis(out, 0, 2).reshape(B, H, S, dv).astype(f32)
    o = o * lax.rsqrt(jnp.mean(jnp.square(o), axis=-1, keepdims=True) + LN_EPS)
    o = o * subln_gain.astype(f32) * (1.0 - lambda_init)
    return o.transpose(0, 2, 1, 3).reshape(B, S, H * dv).astype(v.dtype)


def hierarchical_moe(h, w_group, b_group, w_router, b_router, w1, w3, w2):
    B, S, D = h.shape
    T = B * S
    f32 = jnp.float32
    xt = h.reshape(T, D)
    group_logits = (xt @ w_group).astype(f32) + b_group.astype(f32)
    grp = jnp.argmax(group_logits, axis=-1)
    p_grp = jnp.take_along_axis(jax.nn.softmax(group_logits, axis=-1), grp[:, None], axis=1)[:, 0]
    expert_logits = ((xt @ w_router).astype(f32) + b_router.astype(f32)).reshape(T, N_GROUPS, EXPERTS_PER_GROUP)
    in_group = jnp.take_along_axis(expert_logits, grp[:, None, None], axis=1)[:, 0]
    top_vals, top_idx = lax.top_k(in_group, TOP_K)
    gates = jax.nn.softmax(top_vals, axis=-1) * p_grp[:, None]
    expert_id = (grp[:, None] * EXPERTS_PER_GROUP + top_idx).astype(jnp.int32)
    M = T * TOP_K
    flat_e = expert_id.reshape(M)
    flat_tok = jnp.arange(M, dtype=jnp.int32) // TOP_K
    order = jnp.argsort(flat_e)
    e_sorted = flat_e[order]
    tok_sorted = flat_tok[order]
    gate_sorted = gates.reshape(M)[order]
    counts = jnp.zeros((N_EXPERTS,), jnp.int32).at[flat_e].add(1)
    padded = (counts + MOE_BLOCK - 1) // MOE_BLOCK * MOE_BLOCK
    pad_end = jnp.cumsum(padded)
    pad_start = pad_end - padded
    start = jnp.cumsum(counts) - counts
    dest = pad_start[e_sorted] + jnp.arange(M, dtype=jnp.int32) - start[e_sorted]
    P = M + N_EXPERTS * MOE_BLOCK
    n_blk = P // MOE_BLOCK
    slot_tok = jnp.full((P,), T, jnp.int32).at[dest].set(tok_sorted)
    x_pad = jnp.concatenate([xt, jnp.zeros((1, D), xt.dtype)], axis=0)
    x_slots = x_pad[slot_tok].reshape(n_blk, MOE_BLOCK, D)
    blk_expert = jnp.minimum(
        jnp.searchsorted(pad_end, jnp.arange(n_blk, dtype=jnp.int32) * MOE_BLOCK, side='right'),
        N_EXPERTS - 1)

    def expert_block(args):
        xb, e = args
        return (jax.nn.silu(xb @ w1[e]) * (xb @ w3[e])) @ w2[e]

    y_slots = lax.map(expert_block, (x_slots, blk_expert)).reshape(P, D)
    y = y_slots[dest] * gate_sorted[:, None].astype(y_slots.dtype)
    return jax.ops.segment_sum(y, tok_sorted, num_segments=T).reshape(B, S, D)


def setup_inputs(seed: int = 0) -> dict:
    key = jax.random.key(seed)
    ks = jax.random.split(key, 26)
    D = D_MODEL
    beta = (8.0 * DEPTH) ** -0.25
    nrm = lambda k, shape, s: jax.random.normal(k, shape, jnp.float32) * s
    return {
        'x': nrm(ks[0], (BATCH, SEQ, D), 1.0),
        'c': nrm(ks[1], (BATCH, D), 1.0),
        'ln1_g': 1.0 + nrm(ks[2], (DEPTH, D), 0.02),
        'ln1_b': nrm(ks[3], (DEPTH, D), 0.02),
        'ln2_g': 1.0 + nrm(ks[4], (DEPTH, D), 0.02),
        'ln2_b': nrm(ks[5], (DEPTH, D), 0.02),
        'w_ada': nrm(ks[6], (DEPTH, D, 6 * D), 0.1 * D ** -0.5),
        'b_ada': nrm(ks[7], (DEPTH, 6 * D), 0.01),
        'even_w_in': nrm(ks[8], (N_EVEN, D, EVEN_IN), D ** -0.5),
        'even_w_out': nrm(ks[9], (N_EVEN, EVEN_MIX, D), beta * EVEN_MIX ** -0.5),
        'ret_gn_g': 1.0 + nrm(ks[10], (N_EVEN, RET_WIDTH), 0.02),
        'odd_w_in': nrm(ks[11], (N_ODD, D, ODD_IN), D ** -0.5),
        'odd_w_out': nrm(ks[12], (N_ODD, DIFF_VW, D), beta * DIFF_VW ** -0.5),
        'lambda_q1': nrm(ks[13], (N_ODD, DIFF_HEAD_DIM), 0.1),
        'lambda_k1': nrm(ks[14], (N_ODD, DIFF_HEAD_DIM), 0.1),
        'lambda_q2': nrm(ks[15], (N_ODD, DIFF_HEAD_DIM), 0.1),
        'lambda_k2': nrm(ks[16], (N_ODD, DIFF_HEAD_DIM), 0.1),
        'diff_subln_g': 1.0 + nrm(ks[17], (N_ODD, DIFF_V_DIM), 0.02),
        'moe_w_group': nrm(ks[18], (DEPTH, D, N_GROUPS), D ** -0.5),
        'moe_b_group': nrm(ks[19], (DEPTH, N_GROUPS), 0.01),
        'moe_w_router': nrm(ks[20], (DEPTH, D, N_EXPERTS), D ** -0.5),
        'moe_b_router': nrm(ks[21], (DEPTH, N_EXPERTS), 0.01),
        'moe_w1': nrm(ks[22], (DEPTH, N_EXPERTS, D, EXPERT_FF), D ** -0.5),
        'moe_w3': nrm(ks[23], (DEPTH, N_EXPERTS, D, EXPERT_FF), D ** -0.5),
        'moe_w2': nrm(ks[24], (DEPTH, N_EXPERTS, EXPERT_FF, D), beta * EXPERT_FF ** -0.5),
    }


def reference(x, c, ln1_g, ln1_b, ln2_g, ln2_b, w_ada, b_ada,
              even_w_in, even_w_out, ret_gn_g,
              odd_w_in, odd_w_out, lambda_q1, lambda_k1, lambda_q2, lambda_k2, diff_subln_g,
              moe_w_group, moe_b_group, moe_w_router, moe_b_router, moe_w1, moe_w3, moe_w2):
    B, S, D = x.shape
    alpha = (2.0 * DEPTH) ** 0.25
    cond = jax.nn.silu(c)
    for l in range(DEPTH):
        mod = (cond @ w_ada[l] + b_ada[l])[:, None, :]
        sh1, sc1, g1, sh2, sc2, g2 = jnp.split(mod, 6, axis=-1)
        u = x * (1.0 + sc1) + sh1
        i = l // 2
        if l % 2 == 0:
            proj = u @ even_w_in[i]
            sq, sk, sv, rq, rk, rv, rg = split_cols(proj, [SB_WIDTH] * 3 + [RET_WIDTH] * 4)
            sb_shape = (B, S, SB_HEADS, SB_HEAD_DIM)
            ret_shape = (B, S, RET_HEADS, RET_HEAD_DIM)
            a_out = stick_breaking_attention(sq.reshape(sb_shape), sk.reshape(sb_shape), sv.reshape(sb_shape))
            b_out = retention(rq.reshape(ret_shape), rk.reshape(ret_shape), rv.reshape(ret_shape),
                              rg.reshape(ret_shape), ret_gn_g[i])
            mix = jnp.concatenate([a_out, b_out], axis=-1) @ even_w_out[i]
        else:
            proj = u @ odd_w_in[i]
            dq, dk, dv = split_cols(proj, [DIFF_QK, DIFF_QK, DIFF_VW])
            lambda_init = 0.8 - 0.6 * math.exp(-0.3 * l)
            lam = (jnp.exp(jnp.sum(lambda_q1[i].astype(jnp.float32) * lambda_k1[i].astype(jnp.float32)))
                   - jnp.exp(jnp.sum(lambda_q2[i].astype(jnp.float32) * lambda_k2[i].astype(jnp.float32)))
                   + lambda_init)
            c_out = differential_attention(dq.reshape(B, S, DIFF_HEADS, 2, DIFF_HEAD_DIM),
                                           dk.reshape(B, S, DIFF_HEADS, 2, DIFF_HEAD_DIM),
                                           dv.reshape(B, S, DIFF_HEADS, DIFF_V_DIM),
                                           lam, lambda_init, diff_subln_g[i])
            mix = c_out @ odd_w_out[i]
        x = layer_norm(alpha * x + (1.0 + g1) * mix, ln1_g[l], ln1_b[l])
        u = x * (1.0 + sc2) + sh2
        f = hierarchical_moe(u, moe_w_group[l], moe_b_group[l], moe_w_router[l], moe_b_router[l],
                             moe_w1[l], moe_w3[l], moe_w2[l])
        x = layer_norm(alpha * x + (1.0 + g2) * f, ln2_g[l], ln2_b[l])
    return x
```

```cpp
#include <hip/hip_runtime.h>
#include <stdint.h>
#include <stdio.h>

constexpr int D = 1024, BATCH = 4, SEQ = 8192, T = BATCH * SEQ, DEPTH = 2;
constexpr int EVEN_IN = 3584, ODD_IN = 3072;
constexpr int NEXP = 32, FF = 512, NGRP = 4, EPG = 8;
constexpr int PMAX = 2 * T + NEXP * 256;
constexpr int NTILE_MAX = PMAX / 256;
constexpr float LN_EPS = 1e-5f;
constexpr float ALPHA = 1.41421356237309515f;
constexpr float LOG2E = 1.4426950408889634f;
constexpr float LAMBDA_INIT1 = 0.35550906759f;

constexpr int P0_SQ = 0, P0_SK = 512, P0_SV = 1024, P0_RQ = 1536, P0_RK = 2048, P0_RV = 2560, P0_RG = 3072;
constexpr int P1_Q = 0, P1_K = 1024, P1_V = 2048;

constexpr size_t MiB = 1u << 20;
constexpr size_t WS_CTL = 0, CTL_ZERO_BYTES = 1 * MiB;
constexpr size_t WS_MODP = 1 * MiB;
constexpr size_t WS_MOD = 3 * MiB;
constexpr size_t WS_ROUTE = 4 * MiB;
constexpr size_t WS_KN = 5 * MiB + 64 * 1024;
constexpr size_t WS_WRT = 6 * MiB;
constexpr size_t WS_WIN0 = 8 * MiB, WS_WIN1 = 15 * MiB, WS_WOUT0 = 21 * MiB, WS_WOUT1 = 23 * MiB;
constexpr size_t WS_W13 = 26 * MiB;
constexpr size_t WS_W2 = 154 * MiB;
constexpr size_t WS_U = 218 * MiB;
constexpr size_t WS_MIX = 282 * MiB;
constexpr size_t WS_BIG = 346 * MiB;
constexpr size_t WS_XS = WS_BIG, WS_H = WS_BIG + 144 * MiB;
constexpr size_t WS_STATS = WS_BIG;
constexpr size_t WS_YB = WS_BIG + 8 * MiB;
constexpr size_t WS_INV = WS_BIG + 80 * MiB;
constexpr size_t WS_ZROW = 768 * 1024;
constexpr size_t WS_X1 = WS_MIX;
constexpr size_t WS_END = 570 * MiB;
constexpr size_t RT_TOKE = 0;
constexpr size_t RT_TOKG = 256 * 1024;
constexpr size_t RT_RANK = 512 * 1024;
constexpr size_t RT_SLOT = 768 * 1024;
constexpr size_t RT_TILE = 1024 * 1024;
constexpr int CW_TMO = 0, CW_CODE = 1;
constexpr int CW_CNT = 1024;
constexpr int CW_QDIFF = 65536;
constexpr int CW_QDIFF_OLD = 7424;
constexpr int CW_TCTR = 98304;
constexpr int CW_TT = 131072;
constexpr int CW_KNA = 163840;
constexpr int CW_BGQ = 99328;
constexpr int CW_BGDONE = 99392;
constexpr int CW_BAR = 8192;

typedef unsigned short bf16_t;
__device__ __forceinline__ float bf2f(bf16_t v) { return __uint_as_float((unsigned)v << 16); }
__device__ __forceinline__ unsigned f2bf(float f) { unsigned u = __float_as_uint(f); return (u + 0x7fffu + ((u >> 16) & 1u)) >> 16; }
__device__ __forceinline__ unsigned pk2(float lo, float hi) { return f2bf(lo) | (f2bf(hi) << 16); }
__device__ __forceinline__ float wave_sum(float v) {
#pragma unroll
    for (int o = 1; o < 64; o <<= 1) v += __shfl_xor(v, o);
    return v;
}
__device__ __forceinline__ float silu_f(float v) { return v / (1.f + __expf(-v)); }
#define GAS __attribute__((address_space(1)))
#define LAS __attribute__((address_space(3)))
typedef unsigned v4u __attribute__((ext_vector_type(4)));
typedef unsigned v2u __attribute__((ext_vector_type(2)));
typedef float f32x4 __attribute__((ext_vector_type(4)));
typedef float f32x16 __attribute__((ext_vector_type(16)));
typedef short bf16x8 __attribute__((ext_vector_type(8)));
typedef short s16x4 __attribute__((ext_vector_type(4)));
typedef GAS unsigned gu32;
typedef GAS unsigned long long gu64;
#define RLX_AGENT __ATOMIC_RELAXED, __HIP_MEMORY_SCOPE_AGENT
#define LDS_WAIT() asm volatile("s_waitcnt lgkmcnt(0)" ::: "memory")
#define VM_WAIT() asm volatile("s_waitcnt vmcnt(0)" ::: "memory")
__device__ __forceinline__ unsigned cvtpk_c(float lo, float hi) { unsigned r; asm("v_cvt_pk_bf16_f32 %0, %1, %2" : "=v"(r) : "v"(lo), "v"(hi)); return r; }
#ifndef PG8_WGM
#define PG8_WGM 8
#endif
namespace pg8 {
#define PG8_LAS __attribute__((address_space(3)))
typedef short bf16x8 __attribute__((ext_vector_type(8)));
typedef float f32x4 __attribute__((ext_vector_type(4)));
typedef unsigned u32x4 __attribute__((ext_vector_type(4)));
constexpr int BM = 256, BK = 64, HALF = 128, HTB = HALF * BK * 2  , STAGE_BYTES = 8 * HTB, NXCD = 8, WGM = PG8_WGM;

__host__ __device__ __forceinline__ int lds_byte(int r, int c) { const int st = (r >> 4) * 2 + (c >> 5), rr = r & 15, cc = c & 31, ob = rr * 64 + cc * 2; return st * 1024 + (ob ^ (((ob >> 9) & 1) << 5)); }
__host__ __device__ __forceinline__ void stage_rc(int b, int& R, int& C) { const int st = b / 1024, sb = b % 1024, swz = sb ^ (((sb >> 9) & 1) << 5); R = (st >> 1) * 16 + swz / 64; C = (st & 1) * 32 + (swz % 64) / 2; }
__host__ __device__ __forceinline__ int perm32(int rho) { const int n = rho >> 4, i = rho & 15; return 8 * (i >> 2) + 4 * n + (i & 3); }

struct Unit { int pm, pn; };
struct Gemm { const bf16_t* A; const bf16_t* Bt; int M, N, K; };

struct StaticOrder {
    int nM, nN, nwg, G, c;
    __host__ __device__ void init(int M, int N, int G_, int c_) { nM = M / BM; nN = N / BM; nwg = nM * nN; G = G_; c = c_; }
    __host__ __device__ bool next(int i, Unit& u) const {
        const long L = (long)i * G + c; if (L >= nwg) return false;
        int wgid = (int)L; { const int q = nwg / NXCD, r = nwg % NXCD, xcd = wgid % NXCD, off = wgid / NXCD; wgid = (xcd < r ? xcd * (q + 1) : r * (q + 1) + (xcd - r) * q) + off; }
        const int nig = WGM * nN, gid = wgid / nig, fm = gid * WGM, gsz = (nM - fm) < WGM ? (nM - fm) : WGM;
        u.pm = fm + ((wgid % nig) % gsz); u.pn = (wgid % nig) / gsz; return true;
    }
    __device__ __forceinline__ void a_ready(const Unit&) const {}
    __device__ __forceinline__ void done(const Unit&) const {}
};
__device__ __forceinline__ unsigned cvt_pk_bf16(float lo, float hi) { unsigned r; asm volatile("v_cvt_pk_bf16_f32 %0, %1, %2" : "=v"(r) : "v"(lo), "v"(hi)); return r; }
struct EpiStoreBf16 {
    static constexpr bool PERM = true, AFTER_DRAIN = false;
    bf16_t* O; int ldc; int pnmask;
    __device__ __forceinline__ void operator()(const f32x4 (&acc)[2][2][4][2], const Unit& u, int wr, int wc, int fr, int fq) const {
        const int row0 = u.pm * BM + wr * 64 + fr, col0 = (u.pn & pnmask) * BM + wc * 32 + 8 * fq;
#if defined(PROBE_EPI2)
        for (int rep_ = 0; rep_ < 2; ++rep_) { asm volatile("" ::: "memory");
#endif
#pragma unroll
        for (int ai = 0; ai < 2; ++ai)
#pragma unroll
            for (int m = 0; m < 4; ++m) { bf16_t* rowp = O + (size_t)(row0 + ai * HALF + m * 16) * ldc + col0;
#pragma unroll
                for (int bj = 0; bj < 2; ++bj) { const f32x4 v0 = acc[ai][bj][m][0], v1 = acc[ai][bj][m][1];
                    u32x4 w; w.x = cvt_pk_bf16(v0[0], v0[1]); w.y = cvt_pk_bf16(v0[2], v0[3]); w.z = cvt_pk_bf16(v1[0], v1[1]); w.w = cvt_pk_bf16(v1[2], v1[3]);
                    *(u32x4*)(rowp + bj * HALF) = w; } }
#if defined(PROBE_EPI2)
        }
#endif
    }
};
struct EpiProj1 {
    static constexpr bool PERM = true, AFTER_DRAIN = false;
    bf16_t* O; int ldc; unsigned* kna;
    __device__ __forceinline__ void operator()(const f32x4 (&acc)[2][2][4][2], const Unit& u, int wr, int wc, int fr, int fq) const {
        const int row0 = u.pm * BM + wr * 64 + fr, col0 = u.pn * BM + wc * 32 + 8 * fq;
        const bool isk = (u.pn >= 4) && (u.pn < 8);
#pragma unroll
        for (int ai = 0; ai < 2; ++ai) {
            float mx[2] = {0.f, 0.f};
#pragma unroll
            for (int m = 0; m < 4; ++m) { bf16_t* rowp = O + (size_t)(row0 + ai * HALF + m * 16) * ldc + col0;
#pragma unroll
                for (int bj = 0; bj < 2; ++bj) { const f32x4 v0 = acc[ai][bj][m][0], v1 = acc[ai][bj][m][1];
                    u32x4 w; w.x = cvt_pk_bf16(v0[0], v0[1]); w.y = cvt_pk_bf16(v0[2], v0[3]); w.z = cvt_pk_bf16(v1[0], v1[1]); w.w = cvt_pk_bf16(v1[2], v1[3]);
                    *(u32x4*)(rowp + bj * HALF) = w;
                    if (isk) {
                        const float r0 = __uint_as_float(w.x << 16), r1 = __uint_as_float(w.x & 0xffff0000u), r2 = __uint_as_float(w.y << 16), r3 = __uint_as_float(w.y & 0xffff0000u);
                        const float r4 = __uint_as_float(w.z << 16), r5 = __uint_as_float(w.z & 0xffff0000u), r6 = __uint_as_float(w.w << 16), r7 = __uint_as_float(w.w & 0xffff0000u);
                        float ss = ((r0 * r0 + r1 * r1) + (r2 * r2 + r3 * r3)) + ((r4 * r4 + r5 * r5) + (r6 * r6 + r7 * r7));
                        ss += __shfl_xor(ss, 16); ss += __shfl_xor(ss, 32);
                        mx[bj] = fmaxf(mx[bj], ss); } } }
            if (isk) {
#pragma unroll
                for (int bj = 0; bj < 2; ++bj) { float v = mx[bj];
                    v = fmaxf(v, __shfl_xor(v, 1)); v = fmaxf(v, __shfl_xor(v, 2)); v = fmaxf(v, __shfl_xor(v, 4)); v = fmaxf(v, __shfl_xor(v, 8));
                    if (fr == 0 && fq == 0) { const int grow = u.pm * BM + ai * HALF + wr * 64, b = grow >> 13, tile = (grow & 8191) >> 6, hm = 4 * (u.pn - 4) + 2 * bj + (wc >> 1);
                        atomicMax(kna + (((size_t)b * 16 + hm) * 128 + tile) * 2 + (wc & 1), __float_as_uint(v * 1.0001f)); } } }
        }
    }
};
template <bool XB> struct EpiOut {
    static constexpr bool PERM = true, AFTER_DRAIN = false;
    bf16_t* Y; const void* Xin; const float* g1; float* stats;
    __device__ __forceinline__ void operator()(const f32x4 (&acc)[2][2][4][2], const Unit& u, int wr, int wc, int fr, int fq) const {
        const int row0 = u.pm * BM + wr * 64 + fr, col0 = u.pn * BM + wc * 32 + 8 * fq;
        const float* g = g1 + (size_t)((u.pm * BM) / 8192) * 6144 + col0;
        f32x4 gv[2][2];
#pragma unroll
        for (int bj = 0; bj < 2; ++bj)
#pragma unroll
            for (int n = 0; n < 2; ++n) gv[bj][n] = *(const f32x4*)(g + bj * HALF + 4 * n) + 1.0f;
#pragma unroll
        for (int ai = 0; ai < 2; ++ai)
#pragma unroll
            for (int m = 0; m < 4; ++m) { const int row = row0 + ai * HALF + m * 16; const size_t off = (size_t)row * 1024 + col0; float s1 = 0.f, s2 = 0.f;
#pragma unroll
                for (int bj = 0; bj < 2; ++bj) {
                    f32x4 x0, x1;
                    if (XB) { const u32x4 xv = *(const u32x4*)((const bf16_t*)Xin + off + bj * HALF);
                        x0 = (f32x4){__uint_as_float(xv.x << 16), __uint_as_float(xv.x & 0xffff0000u), __uint_as_float(xv.y << 16), __uint_as_float(xv.y & 0xffff0000u)};
                        x1 = (f32x4){__uint_as_float(xv.z << 16), __uint_as_float(xv.z & 0xffff0000u), __uint_as_float(xv.w << 16), __uint_as_float(xv.w & 0xffff0000u)}; }
                    else { x0 = *(const f32x4*)((const float*)Xin + off + bj * HALF); x1 = *(const f32x4*)((const float*)Xin + off + bj * HALF + 4); }
                    const f32x4 y0 = x0 * 1.41421356237309515f + gv[bj][0] * acc[ai][bj][m][0], y1 = x1 * 1.41421356237309515f + gv[bj][1] * acc[ai][bj][m][1];
                    u32x4 w; w.x = cvt_pk_bf16(y0[0], y0[1]); w.y = cvt_pk_bf16(y0[2], y0[3]); w.z = cvt_pk_bf16(y1[0], y1[1]); w.w = cvt_pk_bf16(y1[2], y1[3]);
                    *(u32x4*)(Y + off + bj * HALF) = w;
                    const float r0 = __uint_as_float(w.x << 16), r1 = __uint_as_float(w.x & 0xffff0000u), r2 = __uint_as_float(w.y << 16), r3 = __uint_as_float(w.y & 0xffff0000u);
                    const float r4 = __uint_as_float(w.z << 16), r5 = __uint_as_float(w.z & 0xffff0000u), r6 = __uint_as_float(w.w << 16), r7 = __uint_as_float(w.w & 0xffff0000u);
                    s1 += ((r0 + r1) + (r2 + r3)) + ((r4 + r5) + (r6 + r7)); s2 += ((r0 * r0 + r1 * r1) + (r2 * r2 + r3 * r3)) + ((r4 * r4 + r5 * r5) + (r6 * r6 + r7 * r7)); }
                s1 += __shfl_xor(s1, 16); s2 += __shfl_xor(s2, 16); s1 += __shfl_xor(s1, 32); s2 += __shfl_xor(s2, 32);
                if (fq == 0) { typedef float f32x2e __attribute__((ext_vector_type(2))); *(f32x2e*)(stats + ((size_t)row * 16 + u.pn * 4 + wc) * 2) = (f32x2e){s1, s2}; } }
    }
};
struct EpiMoe1 {
    static constexpr bool PERM = true, AFTER_DRAIN = false;
    bf16_t* Hh;
    __device__ __forceinline__ void operator()(const f32x4 (&acc)[2][2][4][2], const Unit& u, int wr, int wc, int fr, int fq) const {
        const int row0 = u.pm * BM + wr * 64 + fr, col0 = (u.pn & 3) * HALF + wc * 32 + 8 * fq;
#pragma unroll
        for (int ai = 0; ai < 2; ++ai)
#pragma unroll
            for (int m = 0; m < 4; ++m) { bf16_t* rowp = Hh + (size_t)(row0 + ai * HALF + m * 16) * 512 + col0;
                float h[8];
#pragma unroll
                for (int n = 0; n < 2; ++n)
#pragma unroll
                    for (int i = 0; i < 4; ++i) { const float a = acc[ai][0][m][n][i], b = acc[ai][1][m][n][i]; h[n * 4 + i] = a * b * __builtin_amdgcn_rcpf(1.f + __builtin_amdgcn_exp2f(-1.4426950408889634f * a)); }
                u32x4 w; w.x = cvt_pk_bf16(h[0], h[1]); w.y = cvt_pk_bf16(h[2], h[3]); w.z = cvt_pk_bf16(h[4], h[5]); w.w = cvt_pk_bf16(h[6], h[7]);
                *(u32x4*)rowp = w; }
    }
};
struct MoeOrder {
    const PG8_LAS int* tt; int ntiles, G, c;
    __device__ __forceinline__ void init(const PG8_LAS int* tt_, int G_, int c_) { tt = tt_; ntiles = __builtin_amdgcn_readfirstlane(tt_[511]); G = G_; c = c_; }
    __device__ __forceinline__ bool next(int i, Unit& u) const {
        const int L = i * G + c; if (L >= ntiles * 4) return false;
        const int pm = L >> 2; const int e = __builtin_amdgcn_readfirstlane(tt[pm]); u.pm = pm; u.pn = e * 4 + (L & 3); return true;
    }
    __device__ __forceinline__ void a_ready(const Unit&) const {}
    __device__ __forceinline__ void done(const Unit&) const {}
};
template <class Epi, class Sched, bool ALIGN_EPI = false, bool SP2 = false, bool GATHER = false>
__device__ __forceinline__ void gemm_phase(PG8_LAS unsigned char* lds, const Gemm g, const Sched& S, const Epi& E, const PG8_LAS unsigned* goff = nullptr) {
    static_assert(!GATHER || SP2, "gather is wired into the SP2 loop only");
    int tid_l = threadIdx.x; asm volatile("" : "+v"(tid_l));
    const int tid = tid_l, wid = __builtin_amdgcn_readfirstlane(tid >> 6), lane = tid & 63, wr = wid >> 2, wc = wid & 3, fr = lane & 15, fq = lane >> 4;
    const int K = g.K, nt = K / BK;
    unsigned voffA[2], voffB[2];
#pragma unroll
    for (int i = 0; i < 2; ++i) { int R, C; stage_rc(tid * 16 + i * 8192, R, C); const int Rb = Epi::PERM ? ((R & ~31) + perm32(R & 31)) : R;
        voffA[i] = (unsigned)(R * K + C) * 2u; voffB[i] = (unsigned)(Rb * K + C) * 2u; }
    int gRow[2]; unsigned gCol[2];
#pragma unroll
    for (int i = 0; i < 2; ++i) { int R, C; stage_rc(tid * 16 + i * 8192, R, C); gRow[i] = R; gCol[i] = (unsigned)C * 2u; }
    unsigned gA[2][2] = {{0u, 0u}, {0u, 0u}}, gAn[2][2] = {{0u, 0u}, {0u, 0u}};
#define PG8_GLOAD(dst, u_) do { _Pragma("unroll") for (int h_ = 0; h_ < 2; ++h_) _Pragma("unroll") for (int i_ = 0; i_ < 2; ++i_) dst[h_][i_] = goff[(u_) * 256 + h_ * 128 + gRow[i_]] + gCol[i_]; } while (0)
    const size_t kstep = (size_t)(BK * 2);
    const size_t hstep = (size_t)HALF * K * 2;
    const size_t tstep = 2 * hstep;
    const unsigned ldsw = (unsigned)wid * 1024u;
    const int aoff = lds_byte(wr * 64 + fr, fq * 8), boff = lds_byte(wc * 32 + fr, fq * 8);
#define PG8_SA(b, h) (((b) * 2 + (h)) * HTB)
#define PG8_SB(b, h) ((4 + (b) * 2 + (h)) * HTB)
#define PG8_STAGE(bufoff, gbase, voff) do { _Pragma("unroll") for (int _i = 0; _i < 2; ++_i) \
        __builtin_amdgcn_global_load_lds((const unsigned*)((const char*)(gbase) + (voff)[_i]), (PG8_LAS unsigned*)(lds + (bufoff) + ldsw + _i * 8192), 16, 0, 0); } while (0)
#define PG8_STAGE_A(bufoff, ptr, h, nx) do { if constexpr (GATHER) { unsigned vo_[2]; vo_[0] = (nx) ? gAn[h][0] : gA[h][0]; vo_[1] = (nx) ? gAn[h][1] : gA[h][1]; PG8_STAGE(bufoff, ptr, vo_); } \
        else PG8_STAGE(bufoff, (ptr) + (h) * hstep, voffA); } while (0)
#define PG8_LDA(dst, b, h) do { _Pragma("unroll") for (int m = 0; m < 4; ++m) _Pragma("unroll") for (int k = 0; k < 2; ++k) dst[m][k] = *(const PG8_LAS bf16x8*)(lds + PG8_SA(b, h) + aoff + m * 2048 + k * 1024); } while (0)
#define PG8_LDB(dst, b, h) do { _Pragma("unroll") for (int n = 0; n < 2; ++n) _Pragma("unroll") for (int k = 0; k < 2; ++k) dst[n][k] = *(const PG8_LAS bf16x8*)(lds + PG8_SB(b, h) + boff + n * 2048 + k * 1024); } while (0)
#define PG8_MMA(ai, bj, At, Bt) do { __builtin_amdgcn_s_setprio(1); _Pragma("unroll") for (int m = 0; m < 4; ++m) _Pragma("unroll") for (int n = 0; n < 2; ++n) _Pragma("unroll") for (int k = 0; k < 2; ++k) \
        acc[ai][bj][m][n] = __builtin_amdgcn_mfma_f32_16x16x32_bf16(Bt[n][k], At[m][k], acc[ai][bj][m][n], 0, 0, 0); __builtin_amdgcn_s_setprio(0); } while (0)
#define PG8_WAIT_V(n) asm volatile("s_waitcnt vmcnt(" #n ")" ::: "memory")
#define PG8_WAIT_L(n) asm volatile("s_waitcnt lgkmcnt(" #n ")" ::: "memory")
#define PG8_BAR __builtin_amdgcn_s_barrier()
#define PG8_SCHED __builtin_amdgcn_sched_barrier(0)
    Unit cur, nxt; int ui = 0;
    if (!S.next(0, cur)) return;
    f32x4 acc[2][2][4][2];
#pragma unroll
    for (int a = 0; a < 2; ++a)
#pragma unroll
        for (int b = 0; b < 2; ++b)
#pragma unroll
            for (int m = 0; m < 4; ++m)
#pragma unroll
                for (int n = 0; n < 2; ++n) acc[a][b][m][n] = (f32x4){0.f, 0.f, 0.f, 0.f};
    bf16x8 At[4][2], B0[2][2], B1[2][2];
    const char* cA = (const char*)g.A + (GATHER ? (size_t)0 : (size_t)cur.pm * tstep); const char* cB = (const char*)g.Bt + (size_t)cur.pn * tstep;
    if constexpr (GATHER) PG8_GLOAD(gA, 0);
    S.a_ready(cur);
    if constexpr (SP2) {
        PG8_STAGE(PG8_SB(0, 0), cB, voffB); PG8_STAGE(PG8_SB(0, 1), cB + hstep, voffB); PG8_STAGE_A(PG8_SA(0, 0), cA, 0, false); PG8_STAGE_A(PG8_SA(0, 1), cA, 1, false);
        if (wr == 1) PG8_BAR;
        PG8_WAIT_V(2); PG8_BAR;
        PG8_STAGE(PG8_SB(1, 0), cB + kstep, voffB); PG8_STAGE_A(PG8_SA(1, 0), cA + kstep, 0, false); PG8_STAGE(PG8_SB(1, 1), cB + hstep + kstep, voffB);
        PG8_WAIT_V(6); PG8_BAR;
    } else {
        PG8_STAGE(PG8_SB(0, 0), cB, voffB); PG8_STAGE(PG8_SA(0, 0), cA, voffA); PG8_STAGE(PG8_SB(0, 1), cB + hstep, voffB); PG8_STAGE(PG8_SA(0, 1), cA + hstep, voffA);
        if (wr == 1) PG8_BAR;
        PG8_WAIT_V(4); PG8_BAR;
        PG8_STAGE(PG8_SB(1, 0), cB + kstep, voffB); PG8_STAGE(PG8_SA(1, 0), cA + kstep, voffA); PG8_STAGE(PG8_SB(1, 1), cB + hstep + kstep, voffB);
        PG8_WAIT_V(6); PG8_BAR;
    }
    for (;;) {
        const bool has_next = S.next(ui + 1, nxt);
        if constexpr (GATHER) { if (has_next) PG8_GLOAD(gAn, ui + 1); }
        const char* nA = (has_next && !GATHER) ? (const char*)g.A + (size_t)nxt.pm * tstep : cA; const char* nB = has_next ? (const char*)g.Bt + (size_t)nxt.pn * tstep : cB;
        for (int t = 0; t < nt; t += 2) {
            const bool last = (t == nt - 2);
            const char* a1 = cA + (size_t)(t + 1) * kstep;
            const char* a2 = last ? nA : cA + (size_t)(t + 2) * kstep; const char* b2 = last ? nB : cB + (size_t)(t + 2) * kstep;
            const char* a3 = a2 + kstep; const char* b3 = b2 + kstep;
            if (last && has_next) S.a_ready(nxt);
            const bool nx = last && has_next;
            if constexpr (SP2) {
            PG8_LDB(B0, 0, 0); PG8_LDB(B1, 0, 1); PG8_SCHED; PG8_LDA(At, 0, 0); PG8_STAGE_A(PG8_SA(1, 1), a1, 1, false);
            PG8_WAIT_V(8); PG8_WAIT_L(0); PG8_BAR; PG8_MMA(0, 0, At, B0); PG8_MMA(0, 1, At, B1); PG8_BAR; PG8_SCHED;
            PG8_LDA(At, 0, 1); PG8_STAGE(PG8_SB(0, 0), b2, voffB); PG8_STAGE(PG8_SB(0, 1), b2 + hstep, voffB); PG8_STAGE_A(PG8_SA(0, 0), a2, 0, nx);
            PG8_WAIT_V(8); PG8_WAIT_L(0); PG8_BAR; PG8_MMA(1, 0, At, B0); PG8_MMA(1, 1, At, B1); PG8_BAR; PG8_SCHED;
            PG8_LDB(B0, 1, 0); PG8_LDB(B1, 1, 1); PG8_SCHED; PG8_LDA(At, 1, 0); PG8_STAGE_A(PG8_SA(0, 1), a2, 1, nx);
            PG8_WAIT_V(8); PG8_WAIT_L(0); PG8_BAR; PG8_MMA(0, 0, At, B0); PG8_MMA(0, 1, At, B1); PG8_BAR; PG8_SCHED;
            PG8_LDA(At, 1, 1); PG8_STAGE(PG8_SB(1, 0), b3, voffB); PG8_STAGE(PG8_SB(1, 1), b3 + hstep, voffB); PG8_STAGE_A(PG8_SA(1, 0), a3, 0, nx);
            PG8_WAIT_V(8); PG8_WAIT_L(0); PG8_BAR; PG8_MMA(1, 0, At, B0); PG8_MMA(1, 1, At, B1); PG8_BAR; PG8_SCHED;
            } else {
            PG8_LDB(B0, 0, 0); PG8_SCHED; PG8_LDA(At, 0, 0); PG8_STAGE(PG8_SA(1, 1), a1 + hstep, voffA);
            PG8_WAIT_L(8); PG8_BAR; PG8_WAIT_L(0); PG8_MMA(0, 0, At, B0); PG8_BAR; PG8_SCHED;
            PG8_LDB(B1, 0, 1); PG8_STAGE(PG8_SB(0, 0), b2, voffB);
            PG8_BAR; PG8_WAIT_L(0); PG8_MMA(0, 1, At, B1); PG8_BAR;
            PG8_LDA(At, 0, 1); PG8_STAGE(PG8_SA(0, 0), a2, voffA);
            PG8_BAR; PG8_WAIT_L(0); PG8_MMA(1, 0, At, B0); PG8_BAR; PG8_SCHED;
            PG8_STAGE(PG8_SB(0, 1), b2 + hstep, voffB);
            PG8_WAIT_V(6); PG8_BAR; PG8_MMA(1, 1, At, B1); PG8_BAR;
            PG8_LDB(B0, 1, 0); PG8_SCHED; PG8_LDA(At, 1, 0); PG8_STAGE(PG8_SA(0, 1), a2 + hstep, voffA);
            PG8_WAIT_L(8); PG8_BAR; PG8_WAIT_L(0); PG8_MMA(0, 0, At, B0); PG8_BAR; PG8_SCHED;
            PG8_LDB(B1, 1, 1); PG8_STAGE(PG8_SB(1, 0), b3, voffB);
            PG8_BAR; PG8_WAIT_L(0); PG8_MMA(0, 1, At, B1); PG8_BAR;
            PG8_LDA(At, 1, 1); PG8_STAGE(PG8_SA(1, 0), a3, voffA);
            PG8_BAR; PG8_WAIT_L(0); PG8_MMA(1, 0, At, B0); PG8_BAR; PG8_SCHED;
            PG8_STAGE(PG8_SB(1, 1), b3 + hstep, voffB);
            PG8_WAIT_V(6); PG8_BAR; PG8_MMA(1, 1, At, B1); PG8_BAR;
            }
        }
        if constexpr (ALIGN_EPI) { if (wr == 0) PG8_BAR; }
        if constexpr (!Epi::AFTER_DRAIN) { E(acc, cur, wr, wc, fr, fq); S.done(cur); }
        if (!has_next) break;
#pragma unroll
        for (int a = 0; a < 2; ++a)
#pragma unroll
            for (int b = 0; b < 2; ++b)
#pragma unroll
                for (int m = 0; m < 4; ++m)
#pragma unroll
                    for (int n = 0; n < 2; ++n) acc[a][b][m][n] = (f32x4){0.f, 0.f, 0.f, 0.f};
        cur = nxt; cA = nA; cB = nB; ++ui;
        if constexpr (GATHER) { _Pragma("unroll") for (int h_ = 0; h_ < 2; ++h_) _Pragma("unroll") for (int i_ = 0; i_ < 2; ++i_) gA[h_][i_] = gAn[h_][i_]; }
        if constexpr (ALIGN_EPI) { if (wr == 1) PG8_BAR; }
    }
    PG8_WAIT_V(0);
    if constexpr (!ALIGN_EPI) { if (wr == 0) PG8_BAR; }
    PG8_BAR;
    if constexpr (Epi::AFTER_DRAIN) { E.fused(acc, cur, wr, wc, fr, fq, lds, wid, lane); S.done(cur); }
#undef PG8_SA
#undef PG8_SB
#undef PG8_STAGE
#undef PG8_STAGE_A
#undef PG8_GLOAD
#undef PG8_LDA
#undef PG8_LDB
#undef PG8_MMA
#undef PG8_WAIT_V
#undef PG8_WAIT_L
#undef PG8_BAR
#undef PG8_SCHED
}
}
#define XB_TMO      128
#define XB_XCNT(j)  (256  + 64 * (j))
#define XB_XSUB(j)  (1280 + 64 * (j))
#define XB_XGEN(j)  (2304 + 64 * (j))
#define XB_TOP      3328
#define XB_TOPGEN   3392
#define XCD_BAR_WORDS 3456
#define XB_SPIN_CAP (1u << 18)

__device__ __forceinline__ unsigned xb_ld(unsigned* p)              { return __hip_atomic_load(p, __ATOMIC_RELAXED, __HIP_MEMORY_SCOPE_AGENT); }
__device__ __forceinline__ unsigned xb_add(unsigned* p, unsigned v) { return __hip_atomic_fetch_add(p, v, __ATOMIC_RELAXED, __HIP_MEMORY_SCOPE_AGENT); }
__device__ __forceinline__ unsigned xb_xcc_id() { return (unsigned)__builtin_amdgcn_s_getreg((3 << 11) | 20) & 0xFu; }
#define XB_SPIN(cond, bar) do { unsigned _sp = 0; while (cond) { __builtin_amdgcn_s_sleep(1); \
    if ((++_sp & 255u) == 0u) { if (xb_ld(&(bar)[XB_TMO])) break; if (_sp > XB_SPIN_CAP) { atomicAdd(&(bar)[XB_TMO], 1u); break; } } } } while (0)

struct XcdBarrier {
    unsigned* bar; unsigned x;
    volatile LAS unsigned* st;
};

__device__ __forceinline__ XcdBarrier xcd_barrier_post(unsigned* bar, volatile LAS unsigned* st) {
    XcdBarrier b; b.bar = bar; b.x = xb_xcc_id(); b.st = st;
    if (threadIdx.x == 0) (void)xb_add(&bar[XB_XCNT(b.x)], 1u);
    return b;
}
__device__ __forceinline__ void xcd_barrier_complete(unsigned* bar, unsigned x, unsigned& nloc, unsigned& nx) {
    const unsigned G = gridDim.x * gridDim.y * gridDim.z;
    unsigned sum, cnt, mine, sp = 0u;
    for (;;) {
        sum = 0u; cnt = 0u; mine = 0u;
#pragma unroll
        for (unsigned j = 0; j < 16; ++j) { const unsigned c = xb_ld(&bar[XB_XCNT(j)]); sum += c; cnt += (c > 0u) ? 1u : 0u; mine = (j == x) ? c : mine; }
        if (sum == G) break;
        __builtin_amdgcn_s_sleep(1);
        if ((++sp & 255u) == 0u) { if (xb_ld(&bar[XB_TMO])) break; if (sp > XB_SPIN_CAP) { atomicAdd(&bar[XB_TMO], 1u); break; } }
    }
    nloc = mine > 0u ? mine : 1u; nx = cnt > 0u ? cnt : 1u;
}

__device__ __forceinline__ void xcd_barrier(const XcdBarrier& b) {
    asm volatile("s_waitcnt vmcnt(0)" ::: "memory");
    __syncthreads();
    if (threadIdx.x == 0) {
        unsigned* bar = b.bar;
        __builtin_amdgcn_s_waitcnt(0);
        unsigned nloc = b.st[0], nx = b.st[1];
        if (nloc == 0u) { xcd_barrier_complete(bar, b.x, nloc, nx); b.st[0] = nloc; b.st[1] = nx; }
        const unsigned old = xb_add(&bar[XB_XSUB(b.x)], 1u);
        const unsigned gen = old / nloc;
        if (old + 1u == (gen + 1u) * nloc) {
            __builtin_amdgcn_fence(__ATOMIC_RELEASE, "agent");
            asm volatile("s_waitcnt vmcnt(0)" ::: "memory");
            const unsigned og = xb_add(&bar[XB_TOP], 1u);
            const unsigned tg = og / nx;
            if (og + 1u == (tg + 1u) * nx) xb_add(&bar[XB_TOPGEN], 1u);
            else XB_SPIN(xb_ld(&bar[XB_TOPGEN]) == tg, bar);
            __builtin_amdgcn_fence(__ATOMIC_ACQUIRE, "agent");
            xb_add(&bar[XB_XGEN(b.x)], 1u);
            asm volatile("s_waitcnt vmcnt(0)" ::: "memory");
        } else {
            XB_SPIN(xb_ld(&bar[XB_XGEN(b.x)]) == gen, bar);
            __builtin_amdgcn_fence(__ATOMIC_ACQUIRE, "agent");
            asm volatile("s_waitcnt vmcnt(0)" ::: "memory");
        }
    }
    __syncthreads();
}
constexpr int NWAVES = 8;
constexpr int RING_OFF = 0, RING_BYTES = 131072;
constexpr int LDSCTL_OFF = RING_BYTES, MISC_OFF = LDSCTL_OFF + 320;
constexpr int LDS_BYTES = 147456;
constexpr int TT_LDS_OFF = 132096;
constexpr int GOFF_LDS_OFF = TT_LDS_OFF + 4096, MOE_UMAX = 6;

struct Frame {
    LAS unsigned char* lds;
    volatile LAS unsigned* MISC;
    gu32* ctl;
    int tid, lane, wave, vcu, G;
};

__device__ __forceinline__ void transpose_item(const float* W, int N, bf16_t* WT, int K, int k0, int n0, int row0, float sc, LAS float* scr, int lane) {
    float v[32];
    const float* src = W + (size_t)(k0 + (lane >> 5)) * N + n0 + (lane & 31);
#pragma unroll
    for (int i = 0; i < 32; ++i) v[i] = __builtin_nontemporal_load(src + (size_t)(2 * i) * N);
#pragma unroll
    for (int i = 0; i < 32; ++i) scr[(2 * i + (lane >> 5)) * 33 + (lane & 31)] = v[i];
    LDS_WAIT(); asm volatile("" ::: "memory");
    const int c = lane & 7;
#pragma unroll
    for (int j = 0; j < 4; ++j) { const int n = (lane >> 3) + 8 * j; const LAS float* s = scr + (8 * c) * 33 + n;
        v4u o; o.x = cvtpk_c(s[0 * 33] * sc, s[1 * 33] * sc); o.y = cvtpk_c(s[2 * 33] * sc, s[3 * 33] * sc); o.z = cvtpk_c(s[4 * 33] * sc, s[5 * 33] * sc); o.w = cvtpk_c(s[6 * 33] * sc, s[7 * 33] * sc);
        *(GAS v4u*)(WT + (size_t)(row0 + n) * K + k0 + 8 * c) = o; }
    LDS_WAIT(); asm volatile("" ::: "memory");
}

struct Args {
    const float* in[25]; float* out; unsigned char* ws; int ph_lo, ph_hi;
};

__device__ __forceinline__ void moe_item(const Args& a, unsigned char* ws, int r, LAS float* scr, int lane) {
    constexpr int I_W1 = 16 * 16, I_W2 = 8 * 32;
    const int le = r / (2 * I_W1 + I_W2); int q = r % (2 * I_W1 + I_W2);
    if (q < 2 * I_W1) { const int which = q / I_W1; q %= I_W1; const int nb = q % 16, kb = q / 16, n0 = nb * 32;
        const float* W = a.in[which ? 23 : 22] + (size_t)le * D * FF;
        const int row0 = 256 * (n0 / 128) + 128 * which + (n0 % 128);
        transpose_item(W, FF, (bf16_t*)(ws + WS_W13) + (size_t)le * 1024 * 1024, D, kb * 64, n0, row0, 1.f, scr, lane); }
    else { q -= 2 * I_W1; const int nb = q % 32, kb = q / 32, n0 = nb * 32;
        transpose_item(a.in[24] + (size_t)le * FF * D, D, (bf16_t*)(ws + WS_W2) + (size_t)le * 1024 * 512, FF, kb * 64, n0, n0, 1.f, scr, lane); }
}
constexpr int BG_ITEMS = NEXP * 768, BG_CHUNKS = BG_ITEMS / 8;
__device__ __forceinline__ void bg_pump(Frame& F, const Args& a, const int seam) {
    unsigned char* ws = a.ws;
    LAS float* scr = (LAS float*)(F.lds + RING_OFF + F.wave * 16384);
    LAS int* w = (LAS int*)(F.lds + TT_LDS_OFF + 2048);
    gu32* head = F.ctl + CW_BGQ; gu32* done = F.ctl + CW_BGDONE + 64 * (seam < 0 ? 0 : seam);
    __syncthreads();
    if (F.tid == 0) { int go = 1;
        if (seam >= 0) { const unsigned d = __hip_atomic_fetch_add(done, 1u, RLX_AGENT); if (d + 1u >= (unsigned)F.G) go = 0; }
        w[0] = go ? (int)__hip_atomic_fetch_add(head, 1u, RLX_AGENT) : BG_CHUNKS; }
    __syncthreads();
    for (;;) {
        const int q = w[0];
        __syncthreads();
        if (q >= BG_CHUNKS) break;
        moe_item(a, ws, NEXP * 768 + q * 8 + F.wave, scr, F.lane);
        if (F.tid == 0) { int go = 1;
            if (seam >= 0 && __hip_atomic_load(done, RLX_AGENT) >= (unsigned)F.G) go = 0;
            w[0] = go ? (int)__hip_atomic_fetch_add(head, 1u, RLX_AGENT) : BG_CHUNKS; }
        __syncthreads();
    }
}
enum { PH_PRO_A = 0, PH_PRO_B, PH_L0_PROJ, PH_L0_MIXA, PH_L0_SCAN, PH_L0_MIXB, PH_L0_OUT, PH_L0_LNR, PH_L0_DISP, PH_L0_MOE1, PH_L0_MOE2, PH_L0_COMB,
       PH_L1_PROJ, PH_L1_ATT, PH_L1_OUT, PH_L1_LNR, PH_L1_DISP, PH_L1_MOE1, PH_L1_MOE2, PH_L1_COMB, PH_END };

__device__ __forceinline__ void phase_pro_a(Frame& F, const Args& a) {
    unsigned char* ws = a.ws;
    LAS float* scr = (LAS float*)(F.lds + RING_OFF + F.wave * 16384);
    const int gw = F.vcu * NWAVES + F.wave, NGW = F.G * NWAVES;
    constexpr int I_IN0 = 16 * (EVEN_IN / 32), I_IN1 = 16 * (ODD_IN / 32), I_OUT = 16 * 32, I_W1 = 16 * 16, I_W2 = 8 * 32;
    constexpr int I_MOE = 1 * NEXP * (2 * I_W1 + I_W2);
    constexpr int NITEMS = I_IN0 + I_IN1 + 2 * I_OUT + I_MOE;
    for (int it = gw; it < NITEMS; it += NGW) {
        int r = it;
        if (r < I_IN0) { const int nb = r % (EVEN_IN / 32), kb = r / (EVEN_IN / 32), n0 = nb * 32;
            const float sc = (n0 < 512) ? 0.125f * LOG2E : ((n0 >= P0_RK && n0 < P0_RV) ? 0.08838834764831845f : 1.f);
            transpose_item(a.in[8], EVEN_IN, (bf16_t*)(ws + WS_WIN0), D, kb * 64, n0, n0, sc, scr, F.lane); continue; } r -= I_IN0;
        if (r < I_IN1) { const int nb = r % (ODD_IN / 32), kb = r / (ODD_IN / 32), n0 = nb * 32;
            const float sc = (n0 < 1024) ? 0.125f * LOG2E : 1.f;
            transpose_item(a.in[11], ODD_IN, (bf16_t*)(ws + WS_WIN1), D, kb * 64, n0, n0, sc, scr, F.lane); continue; } r -= I_IN1;
        if (r < I_OUT) { const int nb = r % 32, kb = r / 32; transpose_item(a.in[9], D, (bf16_t*)(ws + WS_WOUT0), D, kb * 64, nb * 32, nb * 32, 1.f, scr, F.lane); continue; } r -= I_OUT;
        if (r < I_OUT) { const int nb = r % 32, kb = r / 32; transpose_item(a.in[12], D, (bf16_t*)(ws + WS_WOUT1), D, kb * 64, nb * 32, nb * 32, 1.f, scr, F.lane); continue; } r -= I_OUT;
        moe_item(a, ws, r, scr, F.lane);
    }
    float* modp = (float*)(ws + WS_MODP);
    for (int task = gw; task < 8 * 2 * 96; task += NGW) {
        const int ks = task / 192, l = (task / 96) % 2, n = (task % 96) * 64 + F.lane;
        const float* w = a.in[6] + ((size_t)l * D + ks * 128) * 6 * D + n; const float* c = a.in[1] + ks * 128;
        float a0 = 0, a1 = 0, a2 = 0, a3 = 0;
#pragma unroll 8
        for (int k = 0; k < 128; ++k) { const float wv = w[(size_t)k * 6 * D];
            a0 += silu_f(c[k]) * wv; a1 += silu_f(c[D + k]) * wv; a2 += silu_f(c[2 * D + k]) * wv; a3 += silu_f(c[3 * D + k]) * wv; }
        float* o = modp + ((size_t)(ks * 2 + l) * 4) * 6 * D + n;
        o[0] = a0; o[6 * D] = a1; o[2 * 6 * D] = a2; o[3 * 6 * D] = a3;
    }
    bf16_t* WrH = (bf16_t*)(ws + WS_WRT); bf16_t* WrL = WrH + DEPTH * 48 * D;
    for (int i = (F.vcu * NWAVES * 64 + F.tid); i < DEPTH * 48 * D; i += F.G * NWAVES * 64) {
        const int l = i / (48 * D), n = (i / D) % 48, k = i % D;
        const float w = (n < 4) ? a.in[18][((size_t)l * D + k) * 4 + n] : (n < 36 ? a.in[20][((size_t)l * D + k) * 32 + (n - 4)] : 0.f);
        const unsigned h = f2bf(w); WrH[i] = (bf16_t)h; WrL[i] = (bf16_t)f2bf(w - __uint_as_float(h << 16));
    }
}

__device__ __forceinline__ void phase_pro_b(Frame& F, const Args& a) {
    unsigned char* ws = a.ws;
    const float* modp = (const float*)(ws + WS_MODP); float* mod = (float*)(ws + WS_MOD);
    for (int i = F.vcu * NWAVES * 64 + F.tid; i < 2 * 4 * 6 * D; i += F.G * NWAVES * 64) {
        const int l = i / (4 * 6 * D), n = i % (6 * D);
        float s = a.in[7][l * 6 * D + n];
#pragma unroll
        for (int ks = 0; ks < 8; ++ks) s += modp[(size_t)ks * 2 * 4 * 6 * D + i];
        mod[i] = s;
    }
    LAS float* ms = (LAS float*)(F.lds + RING_OFF);
    for (int i = F.tid; i < 4 * 2 * D; i += NWAVES * 64) {
        const int b = i / (2 * D), n = i % (2 * D);
        float s = a.in[7][n];
#pragma unroll
        for (int ks = 0; ks < 8; ++ks) s += modp[((size_t)(ks * 2 + 0) * 4 + b) * 6 * D + n];
        ms[i] = s;
    }
    __syncthreads();
    const int gw = F.vcu * NWAVES + F.wave, NGW = F.G * NWAVES;
    bf16_t* U = (bf16_t*)(ws + WS_U); bf16_t* XB = (bf16_t*)a.out + (size_t)T * D;
    for (int blk = gw; blk < T / 16; blk += NGW) {
        const int row0 = blk * 16, b = row0 / SEQ;
        f32x4 ksh[4], ksc[4];
#pragma unroll
        for (int j = 0; j < 4; ++j) { const int c = 4 * F.lane + 256 * j; ksh[j] = *(const LAS f32x4*)(ms + b * 2 * D + c); ksc[j] = *(const LAS f32x4*)(ms + b * 2 * D + D + c) + 1.0f; }
#pragma unroll 4
        for (int i = 0; i < 16; ++i) { const int row = row0 + i; const GAS f32x4* xr = (const GAS f32x4*)(a.in[0] + (size_t)row * D) + F.lane;
#pragma unroll
            for (int j = 0; j < 4; ++j) { const f32x4 v = __builtin_nontemporal_load(xr + 64 * j); const f32x4 u = v * ksc[j] + ksh[j];
                ((GAS unsigned long long*)(U + (size_t)row * D))[F.lane + 64 * j] = (unsigned long long)cvtpk_c(u.x, u.y) | ((unsigned long long)cvtpk_c(u.z, u.w) << 32);
                ((GAS unsigned long long*)(XB + (size_t)row * D))[F.lane + 64 * j] = (unsigned long long)cvtpk_c(v.x, v.y) | ((unsigned long long)cvtpk_c(v.z, v.w) << 32); } }
    }
    __syncthreads();
}
__device__ __forceinline__ int opaque_i(int v) { asm volatile("" : "+v"(v)); return v; }

__device__ __forceinline__ void phase_lnr(Frame& F, const Args& a, const int l, const bool dry = false) {
    unsigned char* ws = a.ws; const bf16_t* Yb = (const bf16_t*)(ws + WS_YB); bf16_t* X1 = (bf16_t*)(ws + WS_X1); bf16_t* U2 = (bf16_t*)(ws + WS_U); int* inv = (int*)(ws + WS_INV);
    const float* mod = (const float*)(ws + WS_MOD); const float* stats = (const float*)(ws + WS_STATS);
    int* tok_e = (int*)(ws + (dry ? WS_KN + 256 * 1024 : WS_ROUTE + RT_TOKE)); float* tok_g = (float*)(ws + (dry ? WS_KN + 512 * 1024 : WS_ROUTE + RT_TOKG)); int* tok_rank = (int*)(ws + (dry ? WS_KN + 768 * 1024 : WS_ROUTE + RT_RANK));
    unsigned* cnt = (unsigned*)(ws + WS_CTL) + (dry ? CW_CNT + 2 * 32 * 64 : CW_CNT + l * 32 * 64);
    const float* lng = a.in[2] + l * D; const float* lnb = a.in[3] + l * D; const float* bgrp = a.in[19] + l * 4; const float* brt = a.in[21] + l * 32;
    const bf16_t* WrH = (const bf16_t*)(ws + WS_WRT) + (size_t)l * 48 * D; const bf16_t* WrL = WrH + DEPTH * 48 * D;
    const int tid = opaque_i(F.tid), lane = tid & 63, wave = F.wave, r = lane & 15, kg = lane >> 4;
    LAS unsigned char* lds = F.lds + RING_OFF;
    LAS float* LG = (LAS float*)lds + wave * (16 * 49);
    LAS unsigned* hist = (LAS unsigned*)(lds + 32768);
    LAS int* pend = (LAS int*)(lds + 32768 + 256);
    LAS float* coef = (LAS float*)(lds + 40960);
    typedef float f32x4m __attribute__((ext_vector_type(4)));
    for (int tile = F.vcu; tile < T / 128; tile += F.G) {
        const int row0 = tile * 128 + wave * 16, row = row0 + r, b = row0 / SEQ;
        const float* m = mod + (size_t)(l * 4 + b) * 6 * D;
        if (tid < 64) hist[tid] = 0u;
        for (int i = tid; i < 1024; i += NWAVES * 64) { coef[i] = lng[i]; coef[1024 + i] = lnb[i]; coef[2048 + i] = 1.0f + m[4 * D + i]; coef[3072 + i] = m[3 * D + i]; }
        float mean, rstd;
        { typedef float f32x2e __attribute__((ext_vector_type(2))); const f32x2e* sp = (const f32x2e*)(stats + ((size_t)row * 16 + kg * 4) * 2);
          float s1 = (sp[0].x + sp[1].x) + (sp[2].x + sp[3].x), s2 = (sp[0].y + sp[1].y) + (sp[2].y + sp[3].y);
          s1 += __shfl_xor(s1, 16); s2 += __shfl_xor(s2, 16); s1 += __shfl_xor(s1, 32); s2 += __shfl_xor(s2, 32);
          mean = s1 * (1.f / D); rstd = rsqrtf(fmaxf(s2 * (1.f / D) - mean * mean, 0.f) + LN_EPS); }
        const bf16_t* yrow = Yb + (size_t)row * D + 8 * kg; bf16_t* x1row = X1 + (size_t)row * D + 8 * kg; bf16_t* u2row = U2 + (size_t)row * D + 8 * kg;
        const bf16_t* wh = WrH + (size_t)r * D + 8 * kg; const bf16_t* wl = WrL + (size_t)r * D + 8 * kg;
        f32x4m acc0 = {0.f, 0.f, 0.f, 0.f}, acc1 = acc0, acc2 = acc0;
        __syncthreads();
#pragma unroll 8
        for (int c = 0; c < 32; ++c) {
            const int k = c * 32;
            const v4u yv = *(const GAS v4u*)(yrow + k);
            const f32x4 y0 = {__uint_as_float(yv.x << 16), __uint_as_float(yv.x & 0xffff0000u), __uint_as_float(yv.y << 16), __uint_as_float(yv.y & 0xffff0000u)}, y1 = {__uint_as_float(yv.z << 16), __uint_as_float(yv.z & 0xffff0000u), __uint_as_float(yv.w << 16), __uint_as_float(yv.w & 0xffff0000u)};
            const int kc = k + 8 * kg;
            const f32x4 g0 = *(const LAS f32x4*)(coef + kc), g1 = *(const LAS f32x4*)(coef + kc + 4), b0 = *(const LAS f32x4*)(coef + 1024 + kc), b1 = *(const LAS f32x4*)(coef + 1024 + kc + 4);
            const f32x4 c0 = *(const LAS f32x4*)(coef + 2048 + kc), c1 = *(const LAS f32x4*)(coef + 2048 + kc + 4), h0 = *(const LAS f32x4*)(coef + 3072 + kc), h1 = *(const LAS f32x4*)(coef + 3072 + kc + 4);
            const f32x4 x0 = (y0 - mean) * rstd * g0 + b0, x1 = (y1 - mean) * rstd * g1 + b1;
            { v4u xw; xw.x = cvtpk_c(x0.x, x0.y); xw.y = cvtpk_c(x0.z, x0.w); xw.z = cvtpk_c(x1.x, x1.y); xw.w = cvtpk_c(x1.z, x1.w); *(GAS v4u*)(x1row + k) = xw; }
            const f32x4 u0 = x0 * c0 + h0, u1 = x1 * c1 + h1;
            v4u uh; uh.x = cvtpk_c(u0.x, u0.y); uh.y = cvtpk_c(u0.z, u0.w); uh.z = cvtpk_c(u1.x, u1.y); uh.w = cvtpk_c(u1.z, u1.w);
            v4u ul;
            ul.x = cvtpk_c(u0.x - __uint_as_float(uh.x << 16), u0.y - __uint_as_float(uh.x & 0xffff0000u)); ul.y = cvtpk_c(u0.z - __uint_as_float(uh.y << 16), u0.w - __uint_as_float(uh.y & 0xffff0000u));
            ul.z = cvtpk_c(u1.x - __uint_as_float(uh.z << 16), u1.y - __uint_as_float(uh.z & 0xffff0000u)); ul.w = cvtpk_c(u1.z - __uint_as_float(uh.w << 16), u1.w - __uint_as_float(uh.w & 0xffff0000u));
            *(GAS v4u*)(u2row + k) = uh;
            const bf16x8 ah = __builtin_bit_cast(bf16x8, uh), al = __builtin_bit_cast(bf16x8, ul);
            const bf16x8 bh0 = *(const GAS bf16x8*)(wh + k), bh1 = *(const GAS bf16x8*)(wh + 16 * D + k), bh2 = *(const GAS bf16x8*)(wh + 32 * D + k);
            acc0 = __builtin_amdgcn_mfma_f32_16x16x32_bf16(ah, bh0, acc0, 0, 0, 0); acc0 = __builtin_amdgcn_mfma_f32_16x16x32_bf16(al, bh0, acc0, 0, 0, 0);
            acc1 = __builtin_amdgcn_mfma_f32_16x16x32_bf16(ah, bh1, acc1, 0, 0, 0); acc1 = __builtin_amdgcn_mfma_f32_16x16x32_bf16(al, bh1, acc1, 0, 0, 0);
            acc2 = __builtin_amdgcn_mfma_f32_16x16x32_bf16(ah, bh2, acc2, 0, 0, 0); acc2 = __builtin_amdgcn_mfma_f32_16x16x32_bf16(al, bh2, acc2, 0, 0, 0);
        }
#pragma unroll
        for (int i = 0; i < 4; ++i) { LG[(4 * kg + i) * 49 + r] = acc0[i]; LG[(4 * kg + i) * 49 + 16 + r] = acc1[i]; LG[(4 * kg + i) * 49 + 32 + r] = acc2[i]; }
        LDS_WAIT();
        if (lane < 16) {
            float lg[36];
#pragma unroll
            for (int n = 0; n < 36; ++n) lg[n] = LG[lane * 49 + n] + (n < 4 ? bgrp[n] : brt[n - 4]);
            int grp = 0; float gm = lg[0];
#pragma unroll
            for (int i = 1; i < 4; ++i) if (lg[i] > gm) { gm = lg[i]; grp = i; }
            float se = 0.f;
#pragma unroll
            for (int i = 0; i < 4; ++i) se += __expf(lg[i] - gm);
            const float pg = 1.f / se;
            float ev[8];
#pragma unroll
            for (int i = 0; i < 8; ++i) ev[i] = grp == 0 ? lg[4 + i] : (grp == 1 ? lg[12 + i] : (grp == 2 ? lg[20 + i] : lg[28 + i]));
            int i1 = 0; float v1 = ev[0];
#pragma unroll
            for (int i = 1; i < 8; ++i) if (ev[i] > v1) { v1 = ev[i]; i1 = i; }
            int i2 = -1; float v2 = -3.0e38f;
#pragma unroll
            for (int i = 0; i < 8; ++i) if (i != i1 && ev[i] > v2) { v2 = ev[i]; i2 = i; }
            const float e2 = __expf(v2 - v1), g1 = pg / (1.f + e2), g2 = pg * e2 / (1.f + e2);
            const int ea = grp * 8 + i1, eb = grp * 8 + i2, rw = row0 + lane;
            tok_e[rw * 2] = ea; tok_e[rw * 2 + 1] = eb; tok_g[rw * 2] = g1; tok_g[rw * 2 + 1] = g2;
            const int ra = (int)__hip_atomic_fetch_add(&hist[ea], 1u, __ATOMIC_RELAXED, __HIP_MEMORY_SCOPE_WORKGROUP), rb = (int)__hip_atomic_fetch_add(&hist[eb], 1u, __ATOMIC_RELAXED, __HIP_MEMORY_SCOPE_WORKGROUP);
            LAS int* pe = pend + (wave * 16 + lane) * 4; pe[0] = ea; pe[1] = eb; pe[2] = ra; pe[3] = rb;
        }
        __syncthreads();
        if (tid < 32) { const unsigned n = hist[tid]; hist[32 + tid] = n ? atomicAdd(cnt + tid * 64, n) : 0u; }
        __syncthreads();
        if (tid < 128) { const LAS int* pe = pend + tid * 4; const int rw = tile * 128 + tid; const int ra = (int)hist[32 + pe[0]] + pe[2], rb = (int)hist[32 + pe[1]] + pe[3];
            tok_rank[rw * 2] = ra; tok_rank[rw * 2 + 1] = rb; inv[pe[0] * 65536 + ra] = rw; inv[pe[1] * 65536 + rb] = rw; }
        __syncthreads();
    }
}

__device__ __forceinline__ void moe_tables(Frame& F, const Args& a, const int l, const bool tiles, const bool gather) {
    unsigned char* ws = a.ws; const unsigned* cnt = (const unsigned*)(ws + WS_CTL) + CW_CNT + l * 32 * 64;
    LAS int* ttl = (LAS int*)(F.lds + TT_LDS_OFF); LAS int* pstart = ttl + 320; LAS int* pcnt = ttl + 360;
    const int tid = opaque_i(F.tid);
    __syncthreads();
    if (tid < 64) {
        const int e = tid & 31; const int c = (int)__hip_atomic_load(cnt + e * 64, RLX_AGENT); const int pad = (c + 255) / 256 * 256;
        int run = pad;
#pragma unroll
        for (int o = 1; o < 32; o <<= 1) { const int t = __shfl_up(run, o, 32); if (e >= o) run += t; }
        const int ps = run - pad;
        if (tid < 32) { pcnt[e] = c; pstart[e] = ps; if (e == 31) { pstart[32] = run; ttl[511] = run >> 8; }
            if (tiles) { for (int t = ps >> 8; t < (run >> 8); ++t) ttl[t] = e; } }
    }
    __syncthreads();
    if (gather) {
        LAS unsigned* goff = (LAS unsigned*)(F.lds + GOFF_LDS_OFF); const int* inv = (const int*)(ws + WS_INV);
        const int nu = ttl[511] * 4;
#pragma unroll
        for (int it = 0; it < MOE_UMAX * 256 / (NWAVES * 64); ++it) { const int s = tid + it * NWAVES * 64; const int i = s >> 8, r = s & 255, L = i * F.G + F.vcu; unsigned off = (unsigned)WS_ZROW;
            if (L < nu) { const int pm = L >> 2, e = ttl[pm], rank = pm * 256 - pstart[e] + r; if (rank < pcnt[e]) off = (unsigned)WS_U + (unsigned)inv[e * 65536 + rank] * 2048u; }
            goff[s] = off; }
        __syncthreads();
    }
}

__device__ __forceinline__ void phase_comb(Frame& F, const Args& a, const int l) {
    unsigned char* ws = a.ws;
    const float* mod = (const float*)(ws + WS_MOD); const bf16_t* Y = (const bf16_t*)(ws + WS_XS); bf16_t* Unext = (bf16_t*)(ws + WS_U); const bf16_t* X1 = (const bf16_t*)(ws + WS_X1);
    const int* tok_e = (const int*)(ws + WS_ROUTE + RT_TOKE); const int* tok_rank = (const int*)(ws + WS_ROUTE + RT_RANK); const float* tok_g = (const float*)(ws + WS_ROUTE + RT_TOKG);
    moe_tables(F, a, l, false, false); const LAS int* pstart = (const LAS int*)(F.lds + TT_LDS_OFF) + 320;
    const float* lng = a.in[4] + l * D; const float* lnb = a.in[5] + l * D;
    const int lane = opaque_i(F.lane);
    const int gw = F.vcu * NWAVES + F.wave, NGW = F.G * NWAVES;
    for (int blk = gw; blk < T / 16; blk += NGW) {
        const int row0 = blk * 16, b = row0 / SEQ;
        const float* m = mod + (size_t)(l * 4 + b) * 6 * D; const float* mn = mod + (size_t)((l + 1) * 4 + b) * 6 * D;
        const int myslot = pstart[tok_e[row0 * 2 + (lane & 31)]] + tok_rank[row0 * 2 + (lane & 31)]; const float mygate = tok_g[row0 * 2 + (lane & 31)];
        f32x4 kg2[4], kln[4], klb[4], ksc[4], ksh[4];
#pragma unroll
        for (int j = 0; j < 4; ++j) { const int c = 4 * lane + 256 * j; kg2[j] = *(const f32x4*)(m + 5 * D + c) + 1.0f; kln[j] = *(const f32x4*)(lng + c); klb[j] = *(const f32x4*)(lnb + c);
            if (l == 0) { ksc[j] = *(const f32x4*)(mn + 1 * D + c) + 1.0f; ksh[j] = *(const f32x4*)(mn + 0 * D + c); } else { ksc[j] = kg2[j]; ksh[j] = kg2[j]; } }
        v2u nx[4], np[4], nq[4];
#define COMB_LOAD(i_) do { const int sa_ = __shfl(myslot, 2 * (i_)), sb_ = __shfl(myslot, 2 * (i_) + 1); \
            const GAS v2u* xr_ = (const GAS v2u*)(X1 + (size_t)(row0 + (i_)) * D) + lane; const GAS v2u* ya_ = (const GAS v2u*)(Y + (size_t)sa_ * D) + lane; const GAS v2u* yb_ = (const GAS v2u*)(Y + (size_t)sb_ * D) + lane; \
            _Pragma("unroll") for (int j = 0; j < 4; ++j) { nx[j] = xr_[64 * j]; np[j] = ya_[64 * j]; nq[j] = yb_[64 * j]; } } while (0)
        COMB_LOAD(0);
        for (int i = 0; i < 16; ++i) {
            v2u cx[4], cp[4], cq[4];
#pragma unroll
            for (int j = 0; j < 4; ++j) { cx[j] = nx[j]; cp[j] = np[j]; cq[j] = nq[j]; }
            const float ga = __shfl(mygate, 2 * i), gb = __shfl(mygate, 2 * i + 1);
            if (i < 15) COMB_LOAD(i + 1);
            const int row = row0 + i;
            f32x4 v[4]; float s = 0.f;
#pragma unroll
            for (int j = 0; j < 4; ++j) {
                const v2u xw = cx[j], p = cp[j], q = cq[j]; const f32x4 g2 = kg2[j];
                const f32x4 x1 = {__uint_as_float(xw.x << 16), __uint_as_float(xw.x & 0xffff0000u), __uint_as_float(xw.y << 16), __uint_as_float(xw.y & 0xffff0000u)};
                f32x4 f;
                f.x = ga * __uint_as_float(p.x << 16) + gb * __uint_as_float(q.x << 16); f.y = ga * __uint_as_float(p.x & 0xffff0000u) + gb * __uint_as_float(q.x & 0xffff0000u);
                f.z = ga * __uint_as_float(p.y << 16) + gb * __uint_as_float(q.y << 16); f.w = ga * __uint_as_float(p.y & 0xffff0000u) + gb * __uint_as_float(q.y & 0xffff0000u);
                v[j] = x1 * ALPHA + g2 * f;
                s += (v[j].x + v[j].y) + (v[j].z + v[j].w);
            }
            const float mean = wave_sum(s) * (1.f / D); float s2 = 0.f;
#pragma unroll
            for (int j = 0; j < 4; ++j) { v[j] = v[j] - mean; s2 += (v[j].x * v[j].x + v[j].y * v[j].y) + (v[j].z * v[j].z + v[j].w * v[j].w); }
            const float rstd = rsqrtf(wave_sum(s2) * (1.f / D) + LN_EPS);
#pragma unroll
            for (int j = 0; j < 4; ++j) {
                const f32x4 x2 = v[j] * rstd * kln[j] + klb[j];
                if (l == 0) {
                    const f32x4 u = x2 * ksc[j] + ksh[j];
                    v2u xw; xw.x = cvtpk_c(x2.x, x2.y); xw.y = cvtpk_c(x2.z, x2.w); ((GAS v2u*)((bf16_t*)a.out + (size_t)row * D))[lane + 64 * j] = xw;
                    v2u uw; uw.x = cvtpk_c(u.x, u.y); uw.y = cvtpk_c(u.z, u.w); ((GAS v2u*)(Unext + (size_t)row * D))[lane + 64 * j] = uw;
                } else ((GAS f32x4*)(a.out + (size_t)row * D))[lane + 64 * j] = x2;
            }
        }
#undef COMB_LOAD
    }
}

typedef short v4i16_t __attribute__((ext_vector_type(4)));
__device__ __forceinline__ int crow(int r, int hi) { return (r & 3) + 8 * (r >> 2) + 4 * hi; }
__device__ __forceinline__ unsigned cvtpk(float lo, float hi) { unsigned r; asm("v_cvt_pk_bf16_f32 %0, %1, %2" : "=v"(r) : "v"(lo), "v"(hi)); return r; }
#define MFMA32(a, b, c) __builtin_amdgcn_mfma_f32_32x32x16_bf16((a), (b), (c), 0, 0, 0)
constexpr int KCH = 1040;

template <int NCH> __device__ __forceinline__ void ktile_load(v4u (&reg)[NCH / 8], const bf16_t* gsrc, int pitch, int tid) {
#pragma unroll
    for (int i = 0; i < NCH / 8; ++i) { const int item = tid + 512 * i, row = item / NCH, c = item % NCH; reg[i] = *(const GAS v4u*)(gsrc + (size_t)row * pitch + c * 8); }
}
template <int NCH> __device__ __forceinline__ void ktile_store(const v4u (&reg)[NCH / 8], LAS unsigned char* dst, int tid) {
#pragma unroll
    for (int i = 0; i < NCH / 8; ++i) { const int item = tid + 512 * i, row = item / NCH, c = item % NCH; *(LAS v4u*)(dst + c * KCH + row * 16) = reg[i]; }
}
__device__ __forceinline__ bf16x8 kfrag(const LAS unsigned char* tile, int blk, int step, int r32, int hi) {
    return *(const LAS bf16x8*)(tile + (step * 2 + hi) * KCH + (blk * 32 + r32) * 16);
}
template <int NDB> __device__ __forceinline__ void vtile_load(v4u (&reg)[NDB / 2], const bf16_t* gsrc, int pitch, int tid) {
#pragma unroll
    for (int i = 0; i < NDB / 2; ++i) { const int item = tid + 512 * i, row = item / (NDB * 4), c = item % (NDB * 4); reg[i] = *(const GAS v4u*)(gsrc + (size_t)row * pitch + c * 8); }
}
template <int NDB> __device__ __forceinline__ void vtile_store(const v4u (&reg)[NDB / 2], LAS unsigned char* dst, int tid) {
#pragma unroll
    for (int i = 0; i < NDB / 2; ++i) { const int item = tid + 512 * i, row = item / (NDB * 4), c = item % (NDB * 4);
        *(LAS v4u*)(dst + ((c >> 2) * 4 + (row >> 4)) * 1024 + (row & 15) * 64 + (c & 3) * 16) = reg[i]; }
}
__device__ __forceinline__ int vfrag_lane_off(int lane) { return ((lane >> 4) & 1) * 32 + (lane & 3) * 8 + (4 * (lane >> 5) + ((lane & 15) >> 2)) * 64; }
__device__ __forceinline__ bf16x8 vfrag(const LAS unsigned char* tile, int db, int s, int laneoff) {
    const LAS unsigned char* p = tile + (db * 4 + s) * 1024 + laneoff;
    const s16x4 lo = __builtin_bit_cast(s16x4, __builtin_amdgcn_ds_read_tr16_b64_v4i16((LAS v4i16_t*)p));
    const s16x4 hi = __builtin_bit_cast(s16x4, __builtin_amdgcn_ds_read_tr16_b64_v4i16((LAS v4i16_t*)(p + 512)));
    return (bf16x8){lo[0], lo[1], lo[2], lo[3], hi[0], hi[1], hi[2], hi[3]};
}
__device__ __forceinline__ int vfragn_lane_off(int lane) { return ((lane >> 4) & 1) * 32 + (lane & 3) * 8 + (8 * (lane >> 5) + ((lane & 15) >> 2)) * 64; }
__device__ __forceinline__ bf16x8 vfragn(const LAS unsigned char* tile, int db, int s, int laneoff) {
    const LAS unsigned char* p = tile + (db * 4 + s) * 1024 + laneoff;
    const s16x4 lo = __builtin_bit_cast(s16x4, __builtin_amdgcn_ds_read_tr16_b64_v4i16((LAS v4i16_t*)p));
    const s16x4 hi = __builtin_bit_cast(s16x4, __builtin_amdgcn_ds_read_tr16_b64_v4i16((LAS v4i16_t*)(p + 256)));
    return (bf16x8){lo[0], lo[1], lo[2], lo[3], hi[0], hi[1], hi[2], hi[3]};
}
__device__ __forceinline__ bf16x8 pfrag(const f32x16& p, int s) {
    v4u w; w.x = cvtpk(p[8 * s + 0], p[8 * s + 1]); w.y = cvtpk(p[8 * s + 2], p[8 * s + 3]); w.z = cvtpk(p[8 * s + 4], p[8 * s + 5]); w.w = cvtpk(p[8 * s + 6], p[8 * s + 7]);
    return __builtin_bit_cast(bf16x8, w);
}

__device__ __forceinline__ void sbdma16(const void* gsrc, LAS unsigned char* dst) { unsigned keep; const unsigned d = (unsigned)__builtin_amdgcn_readfirstlane((int)(unsigned)(uintptr_t)dst);
    asm volatile("s_mov_b32 %0, m0\n\ts_mov_b32 m0, %2\n\ts_nop 0\n\tglobal_load_lds_dwordx4 %1, off\n\ts_mov_b32 m0, %0" : "=&s"(keep) : "v"(gsrc), "s"(d) : "memory"); }
constexpr int S2_K = 0, S2_V = 24576, S2_FLAG = 49152;
template <bool MASKED> __device__ __forceinline__ void sb_scores(f32x16 (&p)[2], float& carry, int kbase, int trow, int hi) {
    float lb[2][16];
#pragma unroll
    for (int blk = 0; blk < 2; ++blk)
#pragma unroll
        for (int r = 0; r < 16; ++r) {
            const float z = p[blk][r]; const bool valid = !MASKED || (kbase + 32 * blk + crow(r, hi)) < trow;
            const float sp = fmaxf(z, 0.f) + __builtin_amdgcn_logf(1.f + __builtin_amdgcn_exp2f(-fabsf(z)));
            lb[blk][r] = valid ? -sp : 0.f; p[blk][r] = valid ? (z - sp) : -1.0e30f;
        }
    float own[8], oth[8];
#pragma unroll
    for (int i = 0; i < 8; ++i) { const int blk = i >> 2, g = i & 3; own[i] = (lb[blk][4 * g] + lb[blk][4 * g + 1]) + (lb[blk][4 * g + 2] + lb[blk][4 * g + 3]); oth[i] = __shfl_xor(own[i], 32); }
    float suf[8]; float run = 0.f;
#pragma unroll
    for (int i = 7; i >= 0; --i) { suf[i] = run; run += own[i] + oth[i]; }
#pragma unroll
    for (int i = 0; i < 8; ++i) {
        const int blk = i >> 2, g = i & 3;
        const float off = carry + suf[i] + (hi == 0 ? oth[i] : 0.f);
        const float b3 = off, b2 = b3 + lb[blk][4 * g + 3], b1 = b2 + lb[blk][4 * g + 2], b0 = b1 + lb[blk][4 * g + 1];
        p[blk][4 * g + 0] = __builtin_amdgcn_exp2f(p[blk][4 * g + 0] + b0); p[blk][4 * g + 1] = __builtin_amdgcn_exp2f(p[blk][4 * g + 1] + b1);
        p[blk][4 * g + 2] = __builtin_amdgcn_exp2f(p[blk][4 * g + 2] + b2); p[blk][4 * g + 3] = __builtin_amdgcn_exp2f(p[blk][4 * g + 3] + b3);
    }
    carry += run;
}
constexpr float SB_CUT = -32.f;
__device__ __forceinline__ void sb_unit2(Frame& F, const bf16_t* proj, bf16_t* mix, int b, int h, int qb) {
    const int tid = opaque_i(F.tid), lane = tid & 63, r32 = lane & 31, hi = lane >> 5, wave = F.wave;
    LAS unsigned char* lds = F.lds + RING_OFF;
    LAS unsigned* flags = (LAS unsigned*)(lds + S2_FLAG);
    const bf16_t* base = proj + (size_t)b * SEQ * EVEN_IN;
    const int q0 = qb * 256, trow = q0 + 32 * wave + r32, mydiag = (q0 + 32 * wave) >> 6, jmax = (q0 >> 6) + 3;
    bf16x8 qr[4];
#pragma unroll
    for (int s = 0; s < 4; ++s) qr[s] = *(const GAS bf16x8*)(base + (size_t)trow * EVEN_IN + P0_SQ + h * 64 + s * 16 + hi * 8);
#pragma unroll
    for (int s = 0; s < 4; ++s) asm volatile("" : "+v"(qr[s]));
    if (tid < 8) flags[tid] = 0u;
    const int krow = 8 * wave + (lane >> 3), kch = (lane & 7) ^ ((krow >> 1) & 7);
    const bf16_t* kg0 = base + (size_t)krow * EVEN_IN + P0_SK + h * 64 + kch * 8;
    const bf16_t* vg0 = base + (size_t)((wave & 3) * 16 + (lane >> 2)) * EVEN_IN + P0_SV + h * 64 + (wave >> 2) * 32 + (lane & 3) * 8;
#define S2_DMA(t, bi) do { const size_t to_ = (size_t)(t) * 64 * EVEN_IN; sbdma16(kg0 + to_, lds + S2_K + (bi) * 8192 + wave * 1024); sbdma16(vg0 + to_, lds + S2_V + (bi) * 8192 + wave * 1024); } while (0)
    const int kswz = (r32 >> 1) & 7, krd = r32 * 128;
#define S2_KFRAG(kt, blk, s) (*(const LAS bf16x8*)((kt) + krd + (blk) * 4096 + ((((s) * 2 + hi) ^ kswz) << 4)))
    const int voff = vfrag_lane_off(lane);
    __syncthreads();
    int bj = jmax % 3;
    S2_DMA(jmax, bj); { const int b1_ = bj == 0 ? 2 : bj - 1; S2_DMA(jmax - 1, b1_); }
    f32x16 o0 = {}, o1 = {};
    float carry = 0.f;
    asm volatile("s_waitcnt vmcnt(2) lgkmcnt(0)" ::: "memory");
    __builtin_amdgcn_s_barrier();
    bool mydone = false, alldone = false;
#define S2_DMA_STEP(j_) do { if ((j_) >= 2) { const int b2_ = bj == 2 ? 0 : bj + 1; S2_DMA((j_) - 2, b2_); } } while (0)
#define S2_END_STEP(done_) do { if (lane == 0) flags[wave] = (done_) ? 1u : 0u; \
        if (j >= 2) asm volatile("s_waitcnt vmcnt(2) lgkmcnt(0)" ::: "memory"); else asm volatile("s_waitcnt vmcnt(0) lgkmcnt(0)" ::: "memory"); \
        __builtin_amdgcn_s_barrier(); asm volatile("" ::: "memory"); bj = bj == 0 ? 2 : bj - 1; unsigned f_ = 1u; _Pragma("unroll") for (int w_ = 0; w_ < 8; ++w_) f_ &= flags[w_]; alldone = f_ != 0u; } while (0)
#define S2_QK(kt_) do { p[0] = (f32x16){}; p[1] = (f32x16){}; _Pragma("unroll") for (int s_ = 0; s_ < 4; ++s_) { p[0] = MFMA32(S2_KFRAG((kt_), 0, s_), qr[s_], p[0]); p[1] = MFMA32(S2_KFRAG((kt_), 1, s_), qr[s_], p[1]); } } while (0)
#define S2_PV(vt_) do { _Pragma("unroll") for (int s_ = 0; s_ < 4; ++s_) { const bf16x8 pf_ = pfrag(p[s_ >> 1], s_ & 1); o0 = MFMA32(vfrag((vt_), 0, s_, voff), pf_, o0); o1 = MFMA32(vfrag((vt_), 1, s_, voff), pf_, o1); } } while (0)
    int j = jmax;
    while (j > mydiag) { S2_DMA_STEP(j); S2_END_STEP(false); --j; }
    {
        S2_DMA_STEP(j);
        const LAS unsigned char* kt = lds + S2_K + bj * 8192; const LAS unsigned char* vt = lds + S2_V + bj * 8192;
        f32x16 p[2]; S2_QK(kt);
        sb_scores<true>(p, carry, j * 64, trow, hi);
        S2_PV(vt);
        mydone = __all(carry < SB_CUT);
        S2_END_STEP(mydone); --j;
    }
    while (j >= 0 && !alldone && !mydone) {
        S2_DMA_STEP(j);
        const LAS unsigned char* kt = lds + S2_K + bj * 8192; const LAS unsigned char* vt = lds + S2_V + bj * 8192;
        f32x16 p[2]; S2_QK(kt);
        sb_scores<false>(p, carry, j * 64, trow, hi);
        S2_PV(vt);
        mydone = __all(carry < SB_CUT);
        S2_END_STEP(mydone); --j;
    }
    while (j >= 0 && !alldone) { S2_DMA_STEP(j); S2_END_STEP(true); --j; }
#undef S2_DMA
#undef S2_KFRAG
#undef S2_DMA_STEP
#undef S2_END_STEP
#undef S2_QK
#undef S2_PV
    asm volatile("s_waitcnt vmcnt(0) lgkmcnt(0)" ::: "memory");
    bf16_t* op = mix + ((size_t)b * SEQ + trow) * D + h * 64;
#pragma unroll
    for (int g = 0; g < 4; ++g) {
        v2u w0; w0.x = cvtpk(o0[4 * g], o0[4 * g + 1]); w0.y = cvtpk(o0[4 * g + 2], o0[4 * g + 3]);
        v2u w1; w1.x = cvtpk(o1[4 * g], o1[4 * g + 1]); w1.y = cvtpk(o1[4 * g + 2], o1[4 * g + 3]);
        *(GAS v2u*)(op + 8 * g + 4 * hi) = w0; *(GAS v2u*)(op + 32 + 8 * g + 4 * hi) = w1;
    }
    __syncthreads();
}

__device__ __forceinline__ float ret_log2gamma(int h) { return __builtin_amdgcn_logf(1.f - __builtin_amdgcn_exp2f(-5.f - (float)h)); }
__device__ __forceinline__ void ret_kv_phase(Frame& F, const bf16_t* proj, bf16_t* state, bf16_t* tot) {
    const int tid = opaque_i(F.tid), lane = tid & 63, r32 = lane & 31, hi = lane >> 5, wave = F.wave;
    LAS unsigned char* lds = F.lds + RING_OFF;
    LAS unsigned char* oimg = lds + 32768;
    const int eb = wave >> 1, voffn = vfragn_lane_off(lane);
    v4u kreg[2], vreg[2];
    for (int gu = F.vcu; gu < 256; gu += F.G) {
        const int bh = gu >> 4, grp = gu & 15, h = bh & 3;
        const float lg2 = ret_log2gamma(h), dec64 = __builtin_amdgcn_exp2f(lg2 * 64.f);
        { const bf16_t* base = proj + ((size_t)(bh >> 2) * SEQ + (grp * 8) * 64) * EVEN_IN;
          vtile_load<4>(kreg, base + P0_RK + h * 128, EVEN_IN, tid); vtile_load<4>(vreg, base + P0_RV + h * 128, EVEN_IN, tid); }
        f32x16 acc[2]; acc[0] = (f32x16){}; acc[1] = (f32x16){};
        for (int j = 0; j <= 8; ++j) {
            const int n = grp * 8 + j;
            if (j < 8) {
#pragma unroll
                for (int i = 0; i < 2; ++i) { const int item = tid + 512 * i, row = item / 16; const float dec = __builtin_amdgcn_exp2f(lg2 * (float)(63 - row));
                    v4u k = kreg[i];
                    k.x = cvtpk_c(__uint_as_float(k.x << 16) * dec, __uint_as_float(k.x & 0xffff0000u) * dec); k.y = cvtpk_c(__uint_as_float(k.y << 16) * dec, __uint_as_float(k.y & 0xffff0000u) * dec);
                    k.z = cvtpk_c(__uint_as_float(k.z << 16) * dec, __uint_as_float(k.z & 0xffff0000u) * dec); k.w = cvtpk_c(__uint_as_float(k.w << 16) * dec, __uint_as_float(k.w & 0xffff0000u) * dec);
                    kreg[i] = k; }
                vtile_store<4>(kreg, lds, tid); vtile_store<4>(vreg, lds + 16384, tid);
                if (j < 7) { const bf16_t* base2 = proj + ((size_t)(bh >> 2) * SEQ + (n + 1) * 64) * EVEN_IN;
                    vtile_load<4>(kreg, base2 + P0_RK + h * 128, EVEN_IN, tid); vtile_load<4>(vreg, base2 + P0_RV + h * 128, EVEN_IN, tid); }
            }
#pragma unroll
            for (int i = 0; i < 2; ++i)
#pragma unroll
                for (int r = 0; r < 16; ++r) *(LAS bf16_t*)(oimg + (eb * 32 + crow(r, hi)) * 272 + ((2 * (wave & 1) + i) * 32 + r32) * 2) = (bf16_t)f2bf(acc[i][r]);
            __syncthreads();
            bf16_t* st = (j < 8) ? state + ((size_t)bh * 128 + n) * 16384 : tot + ((size_t)bh * 16 + grp) * 16384;
#pragma unroll
            for (int i = 0; i < 4; ++i) { const int item = tid + 512 * i, e = item >> 4, c = item & 15; *(GAS v4u*)(st + (size_t)e * 128 + c * 8) = *(const LAS v4u*)(oimg + e * 272 + c * 16); }
            if (j < 8) {
#pragma unroll
                for (int i = 0; i < 2; ++i)
#pragma unroll
                    for (int r = 0; r < 16; ++r) acc[i][r] *= dec64;
#pragma unroll
                for (int s = 0; s < 4; ++s) { const bf16x8 af = vfragn(lds + 16384, eb, s, voffn);
#pragma unroll
                    for (int i = 0; i < 2; ++i) acc[i] = MFMA32(af, vfragn(lds, 2 * (wave & 1) + i, s, voffn), acc[i]); }
            }
            __syncthreads();
        }
    }
}
__device__ __forceinline__ void ret_scan(Frame& F, const bf16_t* tot, bf16_t* gst) {
    const int gt = F.vcu * NWAVES * 64 + opaque_i(F.tid);
    for (int p = gt; p < 16 * 8192; p += F.G * NWAVES * 64) {
        const int bh = p >> 13, pr = p & 8191; const float dec = __builtin_amdgcn_exp2f(ret_log2gamma(bh & 3) * 512.f);
        const GAS unsigned* ptr = (const GAS unsigned*)(tot + (size_t)bh * 16 * 16384) + pr; GAS unsigned* optr = (GAS unsigned*)(gst + (size_t)bh * 16 * 16384) + pr;
        float s0 = 0.f, s1 = 0.f;
#pragma unroll
        for (int g = 0; g < 16; ++g) { const unsigned kv = ptr[(size_t)g * 8192]; optr[(size_t)g * 8192] = cvtpk_c(s0, s1);
            s0 = dec * s0 + __uint_as_float(kv << 16); s1 = dec * s1 + __uint_as_float(kv & 0xffff0000u); }
    }
}
constexpr int RO_LDS_K = 0, RO_LDS_V = 16 * KCH, RO_LDS_ST = RO_LDS_V + 16384;
__device__ __forceinline__ void ret_out_phase(Frame& F, const bf16_t* proj, const bf16_t* state, const bf16_t* gst, const float* gn, bf16_t* mix) {
    const int tid = opaque_i(F.tid), lane = tid & 63, r32 = lane & 31, hi = lane >> 5, wave = F.wave;
    LAS unsigned char* lds = F.lds + RING_OFF;
    v4u kreg[2], vreg[2];
    int u = F.vcu;
    if (u < 2048) { const int bh0 = u >> 7, n0 = u & 127; const bf16_t* base0 = proj + ((size_t)(bh0 >> 2) * SEQ + n0 * 64) * EVEN_IN;
        ktile_load<16>(kreg, base0 + P0_RK + (bh0 & 3) * 128, EVEN_IN, tid); vtile_load<4>(vreg, base0 + P0_RV + (bh0 & 3) * 128, EVEN_IN, tid); }
    for (; u < 2048; u += F.G) {
    const int bh = u >> 7, n = u & 127, b = bh >> 2, h = bh & 3;
    const bf16_t* base = proj + ((size_t)b * SEQ + n * 64) * EVEN_IN;
    const float lg2 = ret_log2gamma(h);
    const int eb = wave >> 1, cb = wave & 1, c = cb * 32 + r32;
    bf16x8 qf[8];
#pragma unroll
    for (int s = 0; s < 8; ++s) qf[s] = *(const GAS bf16x8*)(base + (size_t)c * EVEN_IN + P0_RQ + h * 128 + s * 16 + hi * 8);
    ktile_store<16>(kreg, lds + RO_LDS_K, tid); vtile_store<4>(vreg, lds + RO_LDS_V, tid);
    const bf16_t* st = state + ((size_t)bh * 128 + n) * 16384 + (size_t)(eb * 32 + r32) * 128;
    const bf16_t* sg = gst + ((size_t)bh * 16 + (n >> 3)) * 16384 + (size_t)(eb * 32 + r32) * 128;
    f32x16 oj = {}, og = {};
#pragma unroll
    for (int s = 0; s < 8; ++s) og = MFMA32(*(const GAS bf16x8*)(sg + s * 16 + hi * 8), qf[s], og);
    __builtin_amdgcn_sched_barrier(0);
#pragma unroll
    for (int s = 0; s < 8; ++s) oj = MFMA32(*(const GAS bf16x8*)(st + s * 16 + hi * 8), qf[s], oj);
    { const float gd = __builtin_amdgcn_exp2f(lg2 * (float)(64 * (n & 7)));
#pragma unroll
      for (int r = 0; r < 16; ++r) oj[r] += gd * og[r]; }
    __builtin_amdgcn_sched_barrier(0);
    { const int un = u + F.G; if (un < 2048) { const int bh2 = un >> 7, n2 = un & 127; const bf16_t* base2 = proj + ((size_t)(bh2 >> 2) * SEQ + n2 * 64) * EVEN_IN;
        ktile_load<16>(kreg, base2 + P0_RK + (bh2 & 3) * 128, EVEN_IN, tid); vtile_load<4>(vreg, base2 + P0_RV + (bh2 & 3) * 128, EVEN_IN, tid); } }
    __syncthreads();
    f32x16 p[2]; p[0] = (f32x16){}; p[1] = (f32x16){};
#pragma unroll
    for (int s = 0; s < 8; ++s) { p[0] = MFMA32(kfrag(lds + RO_LDS_K, 0, s, r32, hi), qf[s], p[0]); p[1] = MFMA32(kfrag(lds + RO_LDS_K, 1, s, r32, hi), qf[s], p[1]); }
#pragma unroll
    for (int blk = 0; blk < 2; ++blk)
#pragma unroll
        for (int r = 0; r < 16; ++r) p[blk][r] *= __builtin_amdgcn_exp2f(lg2 * fabsf((float)(c - (32 * blk + crow(r, hi)))));
    const int voff = vfrag_lane_off(lane);
    f32x16 o = {};
#pragma unroll
    for (int s = 0; s < 4; ++s) o = MFMA32(vfrag(lds + RO_LDS_V, eb, s, voff), pfrag(p[s >> 1], s & 1), o);
    const float qd = __builtin_amdgcn_exp2f(lg2 * (float)(c + 1));
    float s1 = 0.f, s2 = 0.f;
#pragma unroll
    for (int r = 0; r < 16; ++r) { o[r] += qd * oj[r]; s1 += o[r]; s2 += o[r] * o[r]; }
    s1 += __shfl_xor(s1, 32); s2 += __shfl_xor(s2, 32);
    typedef float f32x2v __attribute__((ext_vector_type(2)));
    LAS f32x2v* stt = (LAS f32x2v*)(lds + RO_LDS_ST);
    if (hi == 0) stt[eb * 64 + c] = (f32x2v){s1, s2};
    __syncthreads();
    float t1 = 0.f, t2 = 0.f;
#pragma unroll
    for (int i = 0; i < 4; ++i) { const f32x2v v = stt[i * 64 + c]; t1 += v.x; t2 += v.y; }
    const float mu = t1 * (1.f / 128.f), rstd = rsqrtf(fmaxf(t2 * (1.f / 128.f) - mu * mu, 0.f) + LN_EPS);
    const bf16_t* gp = base + (size_t)c * EVEN_IN + P0_RG + h * 128 + eb * 32;
    bf16_t* op = mix + ((size_t)b * SEQ + n * 64 + c) * D + 512 + h * 128 + eb * 32;
    const float* gnp = gn + h * 128 + eb * 32;
#pragma unroll
    for (int g = 0; g < 4; ++g) {
        const int e0 = 8 * g + 4 * hi; const v2u gg = *(const GAS v2u*)(gp + e0); const f32x4 gain = *(const f32x4*)(gnp + e0);
        const float g0 = __uint_as_float(gg.x << 16), g1 = __uint_as_float(gg.x & 0xffff0000u), g2 = __uint_as_float(gg.y << 16), g3 = __uint_as_float(gg.y & 0xffff0000u);
        v2u w; w.x = cvtpk((o[4 * g] - mu) * rstd * gain.x * silu_f(g0), (o[4 * g + 1] - mu) * rstd * gain.y * silu_f(g1));
        w.y = cvtpk((o[4 * g + 2] - mu) * rstd * gain.z * silu_f(g2), (o[4 * g + 3] - mu) * rstd * gain.w * silu_f(g3));
        *(GAS v2u*)(op + e0) = w;
    }
    __syncthreads();
    }
}

__device__ __forceinline__ void phase_mixa0(Frame& F, const Args& a) {
    const bf16_t* proj = (const bf16_t*)(a.ws + WS_BIG); bf16_t* mix = (bf16_t*)(a.ws + WS_MIX); bf16_t* state = (bf16_t*)(a.ws + WS_U);
    ret_kv_phase(F, proj, state, (bf16_t*)a.out);
#if defined(PROBE_MIXA) && PROBE_MIXA == 2
    for (int u = F.vcu; u < 1024; u += F.G) sb_unit2(F, proj, mix, u >> 8, (u >> 5) & 7, u & 31);
#endif
    for (int u = F.vcu; u < 1024; u += F.G) sb_unit2(F, proj, mix, u >> 8, (u >> 5) & 7, u & 31);
}
__device__ __forceinline__ void phase_scan0(Frame& F, const Args& a) { ret_scan(F, (const bf16_t*)a.out, (bf16_t*)a.out + 256 * 16384); }
__device__ __forceinline__ void phase_mixb0(Frame& F, const Args& a) {
    const bf16_t* proj = (const bf16_t*)(a.ws + WS_BIG); bf16_t* mix = (bf16_t*)(a.ws + WS_MIX); const bf16_t* state = (const bf16_t*)(a.ws + WS_U);
    ret_out_phase(F, proj, state, (const bf16_t*)a.out + 256 * 16384, a.in[10], mix);
}

constexpr float DF_THR = 64.f;
__device__ __forceinline__ void dma16(const void* gsrc, LAS unsigned char* dst) { unsigned keep; const unsigned d = (unsigned)__builtin_amdgcn_readfirstlane((int)(unsigned)(uintptr_t)dst);
    asm volatile("s_mov_b32 %0, m0\n\ts_mov_b32 m0, %2\n\ts_nop 0\n\tglobal_load_lds_dwordx4 %1, off\n\ts_mov_b32 m0, %0" : "=&s"(keep) : "v"(gsrc), "s"(d) : "memory"); }
constexpr int D3_K0 = 0, D3_K1 = 32768, D3_V = 65536;
constexpr int D3_KN = TT_LDS_OFF, D3_FLAG = TT_LDS_OFF + 1024, D3_Q = TT_LDS_OFF + 1088;
#ifndef PROBE_CUTX
#define PROBE_CUTX 0.f
#endif
template <int PVAR> __device__ __forceinline__ void diff_unit3(Frame& F, const bf16_t* proj, bf16_t* mix, const float* subg, const float* kn2, float lam, int b, int h, int qb) {
    const int tid = opaque_i(F.tid), lane = tid & 63, r32 = lane & 31, hi = lane >> 5, wave = F.wave, m = wave >> 2, wq = wave & 3;
    LAS unsigned char* lds = F.lds + RING_OFF;
    LAS float* KN = (LAS float*)(F.lds + D3_KN); LAS unsigned* flags = (LAS unsigned*)(F.lds + D3_FLAG);
    const bf16_t* base = proj + (size_t)b * SEQ * ODD_IN;
    const int q0 = qb * 128, trow = q0 + 32 * wq + r32, pmax = qb;
    const float slope2 = __builtin_amdgcn_exp2f(-(float)(h + 1)) * LOG2E;
    bf16x8 qr[4];
#pragma unroll
    for (int s = 0; s < 4; ++s) qr[s] = *(const GAS bf16x8*)(base + (size_t)trow * ODD_IN + P1_Q + h * 128 + m * 64 + s * 16 + hi * 8);
    float qn;
    { float t = 0.f;
#pragma unroll
      for (int s = 0; s < 4; ++s) { const v4u v = __builtin_bit_cast(v4u, qr[s]);
          t += __uint_as_float(v.x << 16) * __uint_as_float(v.x << 16) + __uint_as_float(v.x & 0xffff0000u) * __uint_as_float(v.x & 0xffff0000u);
          t += __uint_as_float(v.y << 16) * __uint_as_float(v.y << 16) + __uint_as_float(v.y & 0xffff0000u) * __uint_as_float(v.y & 0xffff0000u);
          t += __uint_as_float(v.z << 16) * __uint_as_float(v.z << 16) + __uint_as_float(v.z & 0xffff0000u) * __uint_as_float(v.z & 0xffff0000u);
          t += __uint_as_float(v.w << 16) * __uint_as_float(v.w << 16) + __uint_as_float(v.w & 0xffff0000u) * __uint_as_float(v.w & 0xffff0000u); }
      t += __shfl_xor(t, 32); qn = sqrtf(t) * 1.0001f; }
    if (wq == 0) {
        const f32x4 kv = *(const f32x4*)(kn2 + (((size_t)b * 16 + h * 2 + m) * 128 + 2 * lane) * 2);
        float v0 = kv.x + kv.y, v1 = kv.z + kv.w; v1 = fmaxf(v0, v1);
        float run = v1;
#pragma unroll
        for (int o = 1; o < 64; o <<= 1) { const float t = __shfl_up(run, o); if (lane >= o) run = fmaxf(run, t); }
        const float prev = __shfl_up(run, 1);
        KN[m * 128 + 2 * lane] = sqrtf(lane ? fmaxf(prev, v0) : v0); KN[m * 128 + 2 * lane + 1] = sqrtf(run);
    }
    if (tid < 8) flags[tid] = 0u;
    const int krow = 8 * wave + (lane >> 3), kch = (lane & 7) ^ ((krow >> 1) & 7);
    const bf16_t* kg0 = base + (size_t)krow * ODD_IN + P1_K + h * 128 + kch * 8;
    const int vs0 = 2 * wave, vs1 = 2 * wave + 1;
    const bf16_t* vg0 = base + (size_t)((vs0 & 3) * 16 + (lane >> 2)) * ODD_IN + P1_V + h * 128 + (vs0 >> 2) * 32 + (lane & 3) * 8;
    const bf16_t* vg1 = base + (size_t)((vs1 & 3) * 16 + (lane >> 2)) * ODD_IN + P1_V + h * 128 + (vs1 >> 2) * 32 + (lane & 3) * 8;
#define D3_DMA_T(t) do { if (PVAR == 4) break; const size_t to_ = (size_t)(t) * 64 * ODD_IN; const int sl_ = (t) & 3; LAS unsigned char* kb_ = lds + sl_ * 8192 + wave * 1024; LAS unsigned char* vb_ = lds + D3_V + sl_ * 16384; \
        dma16(kg0 + to_, kb_ + D3_K0); dma16(kg0 + to_ + 64, kb_ + D3_K1); dma16(vg0 + to_, vb_ + vs0 * 1024); dma16(vg1 + to_, vb_ + vs1 * 1024); } while (0)
#define D3_DMA_PAIR(p_) do { D3_DMA_T(2 * (p_) + 1); D3_DMA_T(2 * (p_)); } while (0)
    const int kswz = (r32 >> 1) & 7, krd = r32 * 128;
#define D3_KFRAG(kt, blk, s) (*(const LAS bf16x8*)((kt) + krd + (blk) * 4096 + ((((s) * 2 + hi) ^ kswz) << 4)))
    const int voff = vfrag_lane_off(lane);
    __syncthreads();
    D3_DMA_PAIR(pmax); if (pmax >= 1) D3_DMA_PAIR(pmax - 1);
    f32x16 o[4]; o[0] = (f32x16){}; o[1] = (f32x16){}; o[2] = (f32x16){}; o[3] = (f32x16){};
    float mref = -1.0e30f, l = 0.f, skl = 0.f;
    const float tgeo = -__builtin_amdgcn_logf(1.f - __builtin_amdgcn_exp2f(-64.f * slope2));
    if (pmax >= 1) asm volatile("s_waitcnt vmcnt(8) lgkmcnt(0)" ::: "memory"); else asm volatile("s_waitcnt vmcnt(0) lgkmcnt(0)" ::: "memory");
    __builtin_amdgcn_s_barrier();
    bool mydone = false, alldone = false;
    const float c4hi = slope2 * (float)(4 * hi), c32 = slope2 * 32.f;
    bf16x8 vf[2][4];
#define D3_VPRE(vt_) do { _Pragma("unroll") for (int db_ = 0; db_ < 4; ++db_) vf[0][db_] = vfrag((vt_), db_, 0, voff); __builtin_amdgcn_sched_barrier(0); } while (0)
#define D3_PV(vt_, SUB) do { float ls_ = 0.f; _Pragma("unroll") for (int s_ = 0; s_ < 4; ++s_) { \
            if (s_ < 3) { _Pragma("unroll") for (int db_ = 0; db_ < 4; ++db_) vf[(s_ + 1) & 1][db_] = vfrag((vt_), db_, s_ + 1, voff); } \
            f32x16& sc_ = (s_ >> 1) ? sc1 : sc0; \
            _Pragma("unroll") for (int r_ = 8 * (s_ & 1); r_ < 8 * (s_ & 1) + 8; ++r_) { sc_[r_] = __builtin_amdgcn_exp2f(sc_[r_] - (SUB)); ls_ += sc_[r_]; } \
            const bf16x8 pf_ = pfrag(sc_, s_ & 1); \
            _Pragma("unroll") for (int db_ = 0; db_ < 4; ++db_) o[db_] = MFMA32(vf[s_ & 1][db_], pf_, o[db_]); \
            __builtin_amdgcn_sched_barrier(0); } l += ls_; } while (0)
#define D3_DIAG(jt) do { const LAS unsigned char* kt = lds + (m ? D3_K1 : D3_K0) + ((jt) & 3) * 8192; const LAS unsigned char* vt = lds + D3_V + ((jt) & 3) * 16384; \
        f32x16 sc0 = {}, sc1 = {}; bf16x8 kf[4][2]; \
        _Pragma("unroll") for (int s = 0; s < 4; ++s) { kf[s][0] = D3_KFRAG(kt, 0, s); kf[s][1] = D3_KFRAG(kt, 1, s); } \
        __builtin_amdgcn_sched_barrier(0); \
        _Pragma("unroll") for (int s = 0; s < 4; ++s) { sc0 = MFMA32(kf[s][0], qr[s], sc0); sc1 = MFMA32(kf[s][1], qr[s], sc1); } \
        D3_VPRE(vt); \
        const float dq = (float)(trow - (jt) * 64); float mx = -1.0e30f; \
        _Pragma("unroll") for (int r = 0; r < 16; ++r) { sc0[r] -= slope2 * fabsf(dq - (float)crow(r, hi)); sc1[r] -= slope2 * fabsf(dq - (float)(32 + crow(r, hi))); mx = fmaxf(mx, fmaxf(sc0[r], sc1[r])); } \
        mx = fmaxf(mx, __shfl_xor(mx, 32)); mref = mx; l = 0.f; \
        D3_PV(vt, mx); } while (0)
#define D3_NORMAL(jt, knv) do { const float bnd = qn * (knv) - slope2 * (float)(trow - (64 * (jt) + 63)) - mref; \
        if (__all(bnd < -(PROBE_CUTX + 32.f + tgeo))) { mydone = true; break; } \
        if (PVAR == 9) break;          \
        const LAS unsigned char* kt = lds + (m ? D3_K1 : D3_K0) + ((jt) & 3) * 8192; const LAS unsigned char* vt = lds + D3_V + ((jt) & 3) * 16384; \
        f32x16 sc0, sc1; bf16x8 kf[4][2]; \
        _Pragma("unroll") for (int s = 0; s < 4; ++s) { kf[s][0] = D3_KFRAG(kt, 0, s); kf[s][1] = D3_KFRAG(kt, 1, s); } \
        __builtin_amdgcn_sched_barrier(0); \
        { const float loff = slope2 * (float)(64 * (jt) - trow) - mref + c4hi; \
          _Pragma("unroll") for (int r = 0; r < 16; ++r) { sc0[r] = fmaf(slope2, (float)((r & 3) + 8 * (r >> 2)), loff); sc1[r] = sc0[r] + c32; } } \
        _Pragma("unroll") for (int s = 0; s < 4; ++s) { sc0 = MFMA32(kf[s][0], qr[s], sc0); sc1 = MFMA32(kf[s][1], qr[s], sc1); } \
        if (__all(bnd < -20.f)) {         \
            float mq = -1.0e30f; _Pragma("unroll") for (int r = 0; r < 16; ++r) mq = fmaxf(mq, fmaxf(sc0[r], sc1[r])); \
            const float add = 32.f * __builtin_amdgcn_exp2f(mq); if (__all(skl + add <= 0x1p-27f)) { skl += add; break; } } \
        D3_VPRE(vt); \
        if (__any(bnd > DF_THR)) { float mx = -1.0e30f; \
            _Pragma("unroll") for (int r = 0; r < 16; ++r) mx = fmaxf(mx, fmaxf(sc0[r], sc1[r])); \
            mx = fmaxf(mx, __shfl_xor(mx, 32)); \
            if (__any(mx > DF_THR)) { const float dl = fmaxf(mx, 0.f), f = __builtin_amdgcn_exp2f(-dl); mref += dl; l *= f; skl *= f; \
                _Pragma("unroll") for (int db = 0; db < 4; ++db) _Pragma("unroll") for (int r = 0; r < 16; ++r) asm volatile("v_mul_f32 %0, %0, %1" : "+v"(o[db][r]) : "v"(f)); \
                _Pragma("unroll") for (int r = 0; r < 16; ++r) { sc0[r] -= dl; sc1[r] -= dl; } } } \
        D3_PV(vt, 0.f); } while (0)
#define D3_END_STEP(done_) do { if (lane == 0) flags[wave] = (done_) ? 1u : 0u; if (p >= 1) { knA = KN[m * 128 + 2 * p - 1]; knB = KN[m * 128 + 2 * p - 2]; } \
        asm volatile("s_waitcnt vmcnt(0) lgkmcnt(0)" ::: "memory");        \
        __builtin_amdgcn_s_barrier(); asm volatile("" ::: "memory"); unsigned f_ = 1u; _Pragma("unroll") for (int w_ = 0; w_ < 8; ++w_) f_ &= flags[w_]; alldone = f_ != 0u; } while (0)
    if (m) __builtin_amdgcn_s_setprio(1);
    int p = pmax; float knA = 0.f, knB = 0.f;
    {
        if (wq >= 2) { D3_DIAG(2 * p + 1); D3_NORMAL(2 * p, KN[m * 128 + 2 * p]); } else { D3_DIAG(2 * p); }
        D3_END_STEP(mydone); --p;
    }
    while (p >= 0 && !alldone) {
        if (p >= 1) D3_DMA_PAIR(p - 1);
        const float kn1 = knA, kn0 = knB;
        if (!mydone) { D3_NORMAL(2 * p + 1, kn1); }
        if (!mydone) { D3_NORMAL(2 * p, kn0); }
        D3_END_STEP(mydone); --p;
    }
    __builtin_amdgcn_s_setprio(0);
#undef D3_DMA_T
#undef D3_DMA_PAIR
#undef D3_KFRAG
#undef D3_VPRE
#undef D3_PV
#undef D3_DIAG
#undef D3_NORMAL
#undef D3_END_STEP
    asm volatile("s_waitcnt vmcnt(0) lgkmcnt(0)" ::: "memory");
    __syncthreads();
    l += __shfl_xor(l, 32);
    const float inv = 1.f / l;
    LAS float* X = (LAS float*)lds;
    if (m == 1) {
#pragma unroll
        for (int db = 0; db < 4; ++db)
#pragma unroll
            for (int r = 0; r < 16; ++r) X[((wq * 4 + db) * 16 + r) * 64 + lane] = o[db][r] * inv;
    }
    __syncthreads();
    if (m == 0) {
        float ss = 0.f;
#pragma unroll
        for (int db = 0; db < 4; ++db)
#pragma unroll
            for (int r = 0; r < 16; ++r) { const float av = o[db][r] * inv - lam * X[((wq * 4 + db) * 16 + r) * 64 + lane]; o[db][r] = av; ss += av * av; }
        ss += __shfl_xor(ss, 32);
        const float rs = rsqrtf(ss * (1.f / 128.f) + LN_EPS) * (1.f - LAMBDA_INIT1);
        bf16_t* op = mix + ((size_t)b * SEQ + trow) * D + h * 128;
#pragma unroll
        for (int db = 0; db < 4; ++db)
#pragma unroll
            for (int g = 0; g < 4; ++g) { const int e0 = db * 32 + 8 * g + 4 * hi; const f32x4 sg = *(const f32x4*)(subg + e0);
                v2u w; w.x = cvtpk(o[db][4 * g] * rs * sg.x, o[db][4 * g + 1] * rs * sg.y); w.y = cvtpk(o[db][4 * g + 2] * rs * sg.z, o[db][4 * g + 3] * rs * sg.w);
                *(GAS v2u*)(op + e0) = w; }
    }
    __syncthreads();
}
template <int PVAR> __device__ __forceinline__ void phase_diff(Frame& F, const Args& a) {
    const bf16_t* proj = (const bf16_t*)(a.ws + WS_BIG); bf16_t* mix = (bf16_t*)(a.ws + WS_MIX); const float* kn2 = (const float*)((const unsigned*)(a.ws + WS_CTL) + CW_KNA);
    float s1 = 0.f, s2 = 0.f;
    for (int i = 0; i < 64; ++i) { s1 += a.in[13][i] * a.in[14][i]; s2 += a.in[15][i] * a.in[16][i]; }
    const float lam = __expf(s1) - __expf(s2) + LAMBDA_INIT1;
    LAS int* qw = (LAS int*)(F.lds + D3_Q);
    gu32* heads = F.ctl + CW_QDIFF + (PVAR ? 1024 : 0);
    int q = (F.G % 8 == 0) ? (F.vcu / (F.G / 8)) : (int)(blockIdx.x & 7), tries = 0;
    for (;;) {
        if (F.tid == 0) qw[0] = (int)__hip_atomic_fetch_add(heads + 64 * q, 1u, RLX_AGENT);
        __syncthreads();
        const int k = qw[0];
        __syncthreads();
        if (k >= 256) { if (++tries >= 8) break; q = (q + 1) & 7; continue; }
        const int si = k >> 6, qb = 63 - (k & 63), b = q & 3;
        const int h = (q < 4) ? (si == 0 ? 7 : (si == 1 ? 4 : (si == 2 ? 3 : 0))) : (si == 0 ? 6 : (si == 1 ? 5 : (si == 2 ? 2 : 1)));
        diff_unit3<PVAR>(F, proj, mix, a.in[17], kn2, lam, b, h, qb);
    }
}
#ifndef PROBE_DIFFV
#define PROBE_DIFFV 0
#endif
#define PHASE_MIXA if constexpr (l == 0) phase_mixa0(F, a); else { if (PROBE_DIFFV > 0) phase_diff<PROBE_DIFFV>(F, a); phase_diff<0>(F, a); }
#define PHASE_SCAN phase_scan0(F, a);
#define PHASE_MIXB phase_mixb0(F, a);
#define PHASE_LNR phase_lnr(F, a, l, DRY);
#define PHASE_COMB phase_comb(F, a, l);
constexpr int NSLOTS = 22;
#ifndef PROBE_DUP
#define PROBE_DUP (-1)
#endif
#define REP(k) for (int rep_ = 0; rep_ < (((k) == PROBE_DUP) ? 2 : 1); ++rep_)
#define DRYK(k) (((k) == PROBE_DUP) && rep_ == 0)
#ifndef PROBE_OUTX
#define PROBE_OUTX 0
#endif
struct KArgs { const float* in[25]; float* out; unsigned char* ws; int ph_lo, ph_hi, li, pad; };

#define IN(k) (lo <= (k) && (k) < hi)
#if defined(PROBE_BAR2)
#define GRID_BAR(k) do { if ((k) + 1 < hi) { xcd_barrier(bar); xcd_barrier(bar); } } while (0)
#else
#define GRID_BAR(k) do { if ((k) + 1 < hi) xcd_barrier(bar); } while (0)
#endif
template <int l> __device__ __forceinline__ void layer_body(Frame& F, const Args& a, const int lo, const int hi, const XcdBarrier& bar) {
    unsigned char* ws = a.ws;
    bf16_t* U = (bf16_t*)(ws + WS_U); bf16_t* MIX = (bf16_t*)(ws + WS_MIX); bf16_t* PROJ = (bf16_t*)(ws + WS_BIG); bf16_t* XS = (bf16_t*)(ws + WS_XS); bf16_t* Hb = (bf16_t*)(ws + WS_H);
    const float* mod = (const float*)(ws + WS_MOD);
        const int base = 2 + 10 * l;
    if (IN(base + 0)) { REP(base + 0) {
        const int N = l ? ODD_IN : EVEN_IN;
        pg8::Gemm g{U, (const bf16_t*)(ws + (l ? WS_WIN1 : WS_WIN0)), T, N, D}; pg8::StaticOrder S; S.init(T, N, F.G, (int)blockIdx.x);
        if constexpr (l == 0) { pg8::EpiStoreBf16 E{PROJ, N, 0xffff}; pg8::gemm_phase<pg8::EpiStoreBf16, pg8::StaticOrder, true, true>(F.lds + RING_OFF, g, S, E); }
        else { pg8::EpiProj1 E{PROJ, N, (unsigned*)(ws + WS_CTL) + CW_KNA}; pg8::gemm_phase<pg8::EpiProj1, pg8::StaticOrder, true, true>(F.lds + RING_OFF, g, S, E); } }
        GRID_BAR(base + 0);
    }
    if (IN(base + 1)) { REP(base + 1) { PHASE_MIXA } bg_pump(F, a, l == 0 ? 2 : 3); GRID_BAR(base + 1); }
    if (l == 0) {
        if (IN(base + 2)) { PHASE_SCAN GRID_BAR(base + 2); }
        if (IN(base + 3)) { REP(base + 3) { PHASE_MIXB } GRID_BAR(base + 3); }
    }
    if (IN(base + 4)) { REP(base + 4) { const bool DRYO = DRYK(base + 4);
        pg8::Gemm g{MIX, (const bf16_t*)(ws + (l ? WS_WOUT1 : WS_WOUT0)), T, D, D}; pg8::StaticOrder S; S.init(T, D, F.G, (int)blockIdx.x);
        pg8::EpiOut<true> E{(bf16_t*)(ws + WS_YB), (l || (DRYO && PROBE_OUTX == 1)) ? (const void*)a.out : (const void*)((const bf16_t*)a.out + (size_t)T * D), mod + (size_t)l * 4 * 6 * D + 2 * D, (float*)(ws + WS_STATS)};
        pg8::gemm_phase<pg8::EpiOut<true>, pg8::StaticOrder, true, true>(F.lds + RING_OFF, g, S, E); }
        GRID_BAR(base + 4);
    }
    if (IN(base + 5)) { { const bool DRY = false; PHASE_LNR } if (l == 1) bg_pump(F, a, -1); GRID_BAR(base + 5); }
    if (IN(base + 7)) { REP(base + 7) {
        pg8::Gemm g{(const bf16_t*)ws, (const bf16_t*)(ws + WS_W13) + (size_t)l * NEXP * 1024 * 1024, PMAX, 1024, D}; LAS int* ttl = (LAS int*)(F.lds + TT_LDS_OFF); moe_tables(F, a, l, true, true);
        pg8::MoeOrder S; S.init(ttl, F.G, F.vcu);
        pg8::EpiMoe1 E{Hb};
        pg8::gemm_phase<pg8::EpiMoe1, pg8::MoeOrder, true, true, true>(F.lds + RING_OFF, g, S, E, (const LAS unsigned*)(F.lds + GOFF_LDS_OFF)); }
        if (l == 0) bg_pump(F, a, 0);
        GRID_BAR(base + 7);
    }
    if (IN(base + 8)) { REP(base + 8) {
        pg8::Gemm g{Hb, (const bf16_t*)(ws + WS_W2) + (size_t)l * NEXP * 1024 * 512, PMAX, 1024, FF}; LAS int* ttl = (LAS int*)(F.lds + TT_LDS_OFF); moe_tables(F, a, l, true, false);
        pg8::MoeOrder S; S.init(ttl, F.G, F.vcu);
        pg8::EpiStoreBf16 E{XS, D, 3};
        pg8::gemm_phase<pg8::EpiStoreBf16, pg8::MoeOrder, true, true>(F.lds + RING_OFF, g, S, E); }
        if (l == 0) bg_pump(F, a, 1);
        GRID_BAR(base + 8);
    }
    if (IN(base + 9)) { REP(base + 9) { PHASE_COMB } GRID_BAR(base + 9); }
}
#undef IN
#undef GRID_BAR

__global__ void __launch_bounds__(NWAVES * 64, 2) mega(KArgs args) {
    extern __shared__ __attribute__((aligned(16))) unsigned char lds[];
    Frame F;
    F.lds = (LAS unsigned char*)lds;
    F.MISC = (volatile LAS unsigned*)(F.lds + MISC_OFF);
    F.tid = threadIdx.x; F.lane = F.tid & 63; F.wave = __builtin_amdgcn_readfirstlane(F.tid >> 6);
    F.G = gridDim.x; { const int bx = blockIdx.x; F.vcu = (F.G % 8 == 0) ? (bx % 8) * (F.G / 8) + bx / 8 : bx; }
    unsigned char* ws = args.ws;
    F.ctl = (gu32*)(ws + WS_CTL);
    for (int u = F.tid; u < (LDS_BYTES - LDSCTL_OFF) / 4; u += NWAVES * 64) ((LAS unsigned*)(F.lds + LDSCTL_OFF))[u] = 0u;
    __syncthreads();
    const int lo = args.ph_lo, hi = args.ph_hi;
    XcdBarrier bar; bar.bar = (unsigned*)(F.ctl + CW_BAR) + args.li * XCD_BAR_WORDS; bar.x = 0; bar.st = nullptr;
    if (hi - lo > 1) bar = xcd_barrier_post((unsigned*)(F.ctl + CW_BAR) + args.li * XCD_BAR_WORDS, F.MISC + 8);
#define IN(k) (lo <= (k) && (k) < hi)
#define GRID_BAR(k) do { if ((k) + 1 < hi) xcd_barrier(bar); } while (0)

    Args a;
#pragma unroll
    for (int i = 0; i < 25; ++i) a.in[i] = args.in[i];
    a.out = args.out; a.ws = ws; a.ph_lo = lo; a.ph_hi = hi;

    if (IN(0)) { REP(0) { phase_pro_a(F, a); } GRID_BAR(0); }
    if (IN(1)) { REP(1) { phase_pro_b(F, a); } GRID_BAR(1); }

    layer_body<0>(F, a, lo, hi, bar);
    layer_body<1>(F, a, lo, hi, bar);
#if defined(PROBE_XBAR)
    for (int i_ = 0; i_ < PROBE_XBAR; ++i_) xcd_barrier(bar);
#endif
#undef IN
#undef GRID_BAR
}
#define HOST_PLAN \
    MEGA(0, 22);
static int g_grid = 0;
static void launch_mega(const KArgs& base, int lo, int hi, int& li, hipStream_t stream) {
    KArgs a = base; a.ph_lo = lo; a.ph_hi = hi; a.li = li++; a.pad = 0;
    hipLaunchKernelGGL(mega, dim3(g_grid), dim3(NWAVES * 64), LDS_BYTES, stream, a);
}
extern "C" void kernel_launch(void* const* d_in, const int* in_sizes, int n_in, void* d_out, int out_size, void* d_ws, size_t ws_size, hipStream_t stream) {
    if (n_in != 25 || out_size != T * D || ws_size < WS_END) { fprintf(stderr, "kernel_launch: unexpected sizes n_in %d out %d ws %zu (need %zu)\n", n_in, out_size, ws_size, (size_t)WS_END); return; }
    if (g_grid == 0) {
        int dev = 0, cus = 0;
        if (hipGetDevice(&dev) != hipSuccess || hipDeviceGetAttribute(&cus, hipDeviceAttributeMultiprocessorCount, dev) != hipSuccess) { g_grid = -1; return; }
        if (hipFuncSetAttribute((const void*)mega, hipFuncAttributeMaxDynamicSharedMemorySize, LDS_BYTES) != hipSuccess) { g_grid = -1; return; }
        int per_cu = 0; (void)hipOccupancyMaxActiveBlocksPerMultiprocessor(&per_cu, (const void*)mega, NWAVES * 64, LDS_BYTES); (void)hipGetLastError();
        g_grid = cus;
    }
    if (g_grid < 0) return;
    const float* x = (const float*)d_in[0];
    const float *ln1_g = (const float*)d_in[2], *ln1_b = (const float*)d_in[3], *ln2_g = (const float*)d_in[4], *ln2_b = (const float*)d_in[5];
    const float *ret_gn = (const float*)d_in[10];
    const float *lq1 = (const float*)d_in[13], *lk1 = (const float*)d_in[14], *lq2 = (const float*)d_in[15], *lk2 = (const float*)d_in[16], *subg = (const float*)d_in[17];
    const float *bgrp = (const float*)d_in[19], *brt = (const float*)d_in[21];
    unsigned char* ws = (unsigned char*)d_ws; float* out = (float*)d_out;
    unsigned* ctl = (unsigned*)(ws + WS_CTL); float* mod = (float*)(ws + WS_MOD); float* WrT = (float*)(ws + WS_WRT);
    bf16_t *U = (bf16_t*)(ws + WS_U), *MIX = (bf16_t*)(ws + WS_MIX), *PROJ = (bf16_t*)(ws + WS_BIG), *XS = (bf16_t*)(ws + WS_XS);
    int* tok_e = (int*)(ws + WS_ROUTE + RT_TOKE); float* tok_g = (float*)(ws + WS_ROUTE + RT_TOKG); int* tok_rank = (int*)(ws + WS_ROUTE + RT_RANK); int* tok_slot = (int*)(ws + WS_ROUTE + RT_SLOT); int* tile_tab = (int*)(ws + WS_ROUTE + RT_TILE);
    (void)hipMemsetAsync(ws + WS_CTL, 0, CTL_ZERO_BYTES, stream);
    KArgs ka{}; for (int i = 0; i < 25; ++i) ka.in[i] = (const float*)d_in[i]; ka.out = out; ka.ws = ws;
    int li = 0;
#define MEGA(lo, hi) launch_mega(ka, lo, hi, li, stream)
    HOST_PLAN
#undef MEGA
}
```

```cpp
#include <hip/hip_runtime.h>
#include <stdint.h>
#include <stdio.h>

constexpr int D = 1024, BATCH = 4, SEQ = 8192, T = BATCH * SEQ, DEPTH = 2;
constexpr int EVEN_IN = 3584, ODD_IN = 3072;
constexpr int NEXP = 32, FF = 512, NGRP = 4, EPG = 8;
constexpr int PMAX = 2 * T + NEXP * 256;
constexpr int NTILE_MAX = PMAX / 256;
constexpr float LN_EPS = 1e-5f;
constexpr float ALPHA = 1.41421356237309515f;
constexpr float LOG2E = 1.4426950408889634f;
constexpr float LAMBDA_INIT1 = 0.35550906759f;

constexpr int P0_SQ = 0, P0_SK = 512, P0_SV = 1024, P0_RQ = 1536, P0_RK = 2048, P0_RV = 2560, P0_RG = 3072;
constexpr int P1_Q = 0, P1_K = 1024, P1_V = 2048;

constexpr size_t MiB = 1u << 20;
constexpr size_t WS_CTL = 0, CTL_ZERO_BYTES = 1 * MiB;
constexpr size_t WS_MODP = 1 * MiB;
constexpr size_t WS_MOD = 3 * MiB;
constexpr size_t WS_ROUTE = 4 * MiB;
constexpr size_t WS_KN = 5 * MiB + 64 * 1024;
constexpr size_t WS_WRT = 6 * MiB;
constexpr size_t WS_WIN0 = 8 * MiB, WS_WIN1 = 15 * MiB, WS_WOUT0 = 21 * MiB, WS_WOUT1 = 23 * MiB;
constexpr size_t WS_W13 = 26 * MiB;
constexpr size_t WS_W2 = 154 * MiB;
constexpr size_t WS_U = 218 * MiB;
constexpr size_t WS_MIX = 282 * MiB;
constexpr size_t WS_BIG = 346 * MiB;
constexpr size_t WS_XS = WS_BIG, WS_H = WS_BIG + 144 * MiB;
constexpr size_t WS_STATS = WS_BIG;
constexpr size_t WS_INV = WS_BIG + 80 * MiB;
constexpr size_t WS_ZROW = 768 * 1024;
constexpr size_t WS_Y = WS_U;
constexpr size_t WS_U2 = WS_MIX;
constexpr size_t WS_END = 570 * MiB;
constexpr size_t RT_TOKE = 0;
constexpr size_t RT_TOKG = 256 * 1024;
constexpr size_t RT_RANK = 512 * 1024;
constexpr size_t RT_SLOT = 768 * 1024;
constexpr size_t RT_TILE = 1024 * 1024;
constexpr int CW_TMO = 0, CW_CODE = 1;
constexpr int CW_CNT = 1024;
constexpr int CW_QDIFF = 65536;
constexpr int CW_QDIFF_OLD = 7424;
constexpr int CW_TCTR = 98304;
constexpr int CW_TT = 131072;
constexpr int CW_KNA = 163840;
constexpr int CW_BGQ = 99328;
constexpr int CW_BGDONE = 99392;
constexpr int CW_BAR = 8192;

typedef unsigned short bf16_t;
__device__ __forceinline__ float bf2f(bf16_t v) { return __uint_as_float((unsigned)v << 16); }
__device__ __forceinline__ unsigned f2bf(float f) { unsigned u = __float_as_uint(f); return (u + 0x7fffu + ((u >> 16) & 1u)) >> 16; }
__device__ __forceinline__ unsigned pk2(float lo, float hi) { return f2bf(lo) | (f2bf(hi) << 16); }
__device__ __forceinline__ float wave_sum(float v) {
#pragma unroll
    for (int o = 1; o < 64; o <<= 1) v += __shfl_xor(v, o);
    return v;
}
__device__ __forceinline__ float silu_f(float v) { return v / (1.f + __expf(-v)); }
#define GAS __attribute__((address_space(1)))
#define LAS __attribute__((address_space(3)))
typedef unsigned v4u __attribute__((ext_vector_type(4)));
typedef unsigned v2u __attribute__((ext_vector_type(2)));
typedef float f32x4 __attribute__((ext_vector_type(4)));
typedef float f32x16 __attribute__((ext_vector_type(16)));
typedef short bf16x8 __attribute__((ext_vector_type(8)));
typedef short s16x4 __attribute__((ext_vector_type(4)));
typedef GAS unsigned gu32;
typedef GAS unsigned long long gu64;
#define RLX_AGENT __ATOMIC_RELAXED, __HIP_MEMORY_SCOPE_AGENT
#define LDS_WAIT() asm volatile("s_waitcnt lgkmcnt(0)" ::: "memory")
#define VM_WAIT() asm volatile("s_waitcnt vmcnt(0)" ::: "memory")
__device__ __forceinline__ unsigned cvtpk_c(float lo, float hi) { unsigned r; asm("v_cvt_pk_bf16_f32 %0, %1, %2" : "=v"(r) : "v"(lo), "v"(hi)); return r; }
#ifndef PG8_WGM
#define PG8_WGM 8
#endif
namespace pg8 {
#define PG8_LAS __attribute__((address_space(3)))
typedef short bf16x8 __attribute__((ext_vector_type(8)));
typedef float f32x4 __attribute__((ext_vector_type(4)));
typedef unsigned u32x4 __attribute__((ext_vector_type(4)));
constexpr int BM = 256, BK = 64, HALF = 128, HTB = HALF * BK * 2  , STAGE_BYTES = 8 * HTB, NXCD = 8, WGM = PG8_WGM;

__host__ __device__ __forceinline__ int lds_byte(int r, int c) { const int st = (r >> 4) * 2 + (c >> 5), rr = r & 15, cc = c & 31, ob = rr * 64 + cc * 2; return st * 1024 + (ob ^ (((ob >> 9) & 1) << 5)); }
__host__ __device__ __forceinline__ void stage_rc(int b, int& R, int& C) { const int st = b / 1024, sb = b % 1024, swz = sb ^ (((sb >> 9) & 1) << 5); R = (st >> 1) * 16 + swz / 64; C = (st & 1) * 32 + (swz % 64) / 2; }
__host__ __device__ __forceinline__ int perm32(int rho) { const int n = rho >> 4, i = rho & 15; return 8 * (i >> 2) + 4 * n + (i & 3); }

struct Unit { int pm, pn; };
struct Gemm { const bf16_t* A; const bf16_t* Bt; int M, N, K; };

struct StaticOrder {
    int nM, nN, nwg, G, c;
    __host__ __device__ void init(int M, int N, int G_, int c_) { nM = M / BM; nN = N / BM; nwg = nM * nN; G = G_; c = c_; }
    __host__ __device__ bool next(int i, Unit& u) const {
        const long L = (long)i * G + c; if (L >= nwg) return false;
        int wgid = (int)L; { const int q = nwg / NXCD, r = nwg % NXCD, xcd = wgid % NXCD, off = wgid / NXCD; wgid = (xcd < r ? xcd * (q + 1) : r * (q + 1) + (xcd - r) * q) + off; }
        const int nig = WGM * nN, gid = wgid / nig, fm = gid * WGM, gsz = (nM - fm) < WGM ? (nM - fm) : WGM;
        u.pm = fm + ((wgid % nig) % gsz); u.pn = (wgid % nig) / gsz; return true;
    }
    __device__ __forceinline__ void a_ready(const Unit&) const {}
    __device__ __forceinline__ void done(const Unit&) const {}
};
__device__ __forceinline__ unsigned cvt_pk_bf16(float lo, float hi) { unsigned r; asm volatile("v_cvt_pk_bf16_f32 %0, %1, %2" : "=v"(r) : "v"(lo), "v"(hi)); return r; }
struct EpiStoreBf16 {
    static constexpr bool PERM = true, AFTER_DRAIN = false;
    bf16_t* O; int ldc; int pnmask;
    __device__ __forceinline__ void operator()(const f32x4 (&acc)[2][2][4][2], const Unit& u, int wr, int wc, int fr, int fq) const {
        const int row0 = u.pm * BM + wr * 64 + fr, col0 = (u.pn & pnmask) * BM + wc * 32 + 8 * fq;
#if defined(PROBE_EPI2)
        for (int rep_ = 0; rep_ < 2; ++rep_) { asm volatile("" ::: "memory");
#endif
#pragma unroll
        for (int ai = 0; ai < 2; ++ai)
#pragma unroll
            for (int m = 0; m < 4; ++m) { bf16_t* rowp = O + (size_t)(row0 + ai * HALF + m * 16) * ldc + col0;
#pragma unroll
                for (int bj = 0; bj < 2; ++bj) { const f32x4 v0 = acc[ai][bj][m][0], v1 = acc[ai][bj][m][1];
                    u32x4 w; w.x = cvt_pk_bf16(v0[0], v0[1]); w.y = cvt_pk_bf16(v0[2], v0[3]); w.z = cvt_pk_bf16(v1[0], v1[1]); w.w = cvt_pk_bf16(v1[2], v1[3]);
                    *(u32x4*)(rowp + bj * HALF) = w; } }
#if defined(PROBE_EPI2)
        }
#endif
    }
};
struct EpiProj1 {
    static constexpr bool PERM = true, AFTER_DRAIN = false;
    bf16_t* O; int ldc; unsigned* kna;
    __device__ __forceinline__ void operator()(const f32x4 (&acc)[2][2][4][2], const Unit& u, int wr, int wc, int fr, int fq) const {
        const int row0 = u.pm * BM + wr * 64 + fr, col0 = u.pn * BM + wc * 32 + 8 * fq;
        const bool isk = (u.pn >= 4) && (u.pn < 8);
#pragma unroll
        for (int ai = 0; ai < 2; ++ai) {
            float mx[2] = {0.f, 0.f};
#pragma unroll
            for (int m = 0; m < 4; ++m) { bf16_t* rowp = O + (size_t)(row0 + ai * HALF + m * 16) * ldc + col0;
#pragma unroll
                for (int bj = 0; bj < 2; ++bj) { const f32x4 v0 = acc[ai][bj][m][0], v1 = acc[ai][bj][m][1];
                    u32x4 w; w.x = cvt_pk_bf16(v0[0], v0[1]); w.y = cvt_pk_bf16(v0[2], v0[3]); w.z = cvt_pk_bf16(v1[0], v1[1]); w.w = cvt_pk_bf16(v1[2], v1[3]);
                    *(u32x4*)(rowp + bj * HALF) = w;
                    if (isk) {
                        const float r0 = __uint_as_float(w.x << 16), r1 = __uint_as_float(w.x & 0xffff0000u), r2 = __uint_as_float(w.y << 16), r3 = __uint_as_float(w.y & 0xffff0000u);
                        const float r4 = __uint_as_float(w.z << 16), r5 = __uint_as_float(w.z & 0xffff0000u), r6 = __uint_as_float(w.w << 16), r7 = __uint_as_float(w.w & 0xffff0000u);
                        float ss = ((r0 * r0 + r1 * r1) + (r2 * r2 + r3 * r3)) + ((r4 * r4 + r5 * r5) + (r6 * r6 + r7 * r7));
                        ss += __shfl_xor(ss, 16); ss += __shfl_xor(ss, 32);
                        mx[bj] = fmaxf(mx[bj], ss); } } }
            if (isk) {
#pragma unroll
                for (int bj = 0; bj < 2; ++bj) { float v = mx[bj];
                    v = fmaxf(v, __shfl_xor(v, 1)); v = fmaxf(v, __shfl_xor(v, 2)); v = fmaxf(v, __shfl_xor(v, 4)); v = fmaxf(v, __shfl_xor(v, 8));
                    if (fr == 0 && fq == 0) { const int grow = u.pm * BM + ai * HALF + wr * 64, b = grow >> 13, tile = (grow & 8191) >> 6, hm = 4 * (u.pn - 4) + 2 * bj + (wc >> 1);
                        atomicMax(kna + (((size_t)b * 16 + hm) * 128 + tile) * 2 + (wc & 1), __float_as_uint(v * 1.0001f)); } } }
        }
    }
};
template <bool XB> struct EpiOut {
    static constexpr bool PERM = true, AFTER_DRAIN = false;
    bf16_t* Y; const void* Xin; const float* g1; float* stats;
    __device__ __forceinline__ void operator()(const f32x4 (&acc)[2][2][4][2], const Unit& u, int wr, int wc, int fr, int fq) const {
        const int row0 = u.pm * BM + wr * 64 + fr, col0 = u.pn * BM + wc * 32 + 8 * fq;
        const float* g = g1 + (size_t)((u.pm * BM) / 8192) * 6144 + col0;
        f32x4 gv[2][2];
#pragma unroll
        for (int bj = 0; bj < 2; ++bj)
#pragma unroll
            for (int n = 0; n < 2; ++n) gv[bj][n] = *(const f32x4*)(g + bj * HALF + 4 * n) + 1.0f;
#pragma unroll
        for (int ai = 0; ai < 2; ++ai)
#pragma unroll
            for (int m = 0; m < 4; ++m) { const int row = row0 + ai * HALF + m * 16; const size_t off = (size_t)row * 1024 + col0; float s1 = 0.f, s2 = 0.f;
#pragma unroll
                for (int bj = 0; bj < 2; ++bj) {
                    f32x4 x0, x1;
                    if (XB) { const u32x4 xv = *(const u32x4*)((const bf16_t*)Xin + off + bj * HALF);
                        x0 = (f32x4){__uint_as_float(xv.x << 16), __uint_as_float(xv.x & 0xffff0000u), __uint_as_float(xv.y << 16), __uint_as_float(xv.y & 0xffff0000u)};
                        x1 = (f32x4){__uint_as_float(xv.z << 16), __uint_as_float(xv.z & 0xffff0000u), __uint_as_float(xv.w << 16), __uint_as_float(xv.w & 0xffff0000u)}; }
                    else { x0 = *(const f32x4*)((const float*)Xin + off + bj * HALF); x1 = *(const f32x4*)((const float*)Xin + off + bj * HALF + 4); }
                    const f32x4 y0 = x0 * 1.41421356237309515f + gv[bj][0] * acc[ai][bj][m][0], y1 = x1 * 1.41421356237309515f + gv[bj][1] * acc[ai][bj][m][1];
                    u32x4 w; w.x = cvt_pk_bf16(y0[0], y0[1]); w.y = cvt_pk_bf16(y0[2], y0[3]); w.z = cvt_pk_bf16(y1[0], y1[1]); w.w = cvt_pk_bf16(y1[2], y1[3]);
                    *(u32x4*)(Y + off + bj * HALF) = w;
                    const float r0 = __uint_as_float(w.x << 16), r1 = __uint_as_float(w.x & 0xffff0000u), r2 = __uint_as_float(w.y << 16), r3 = __uint_as_float(w.y & 0xffff0000u);
                    const float r4 = __uint_as_float(w.z << 16), r5 = __uint_as_float(w.z & 0xffff0000u), r6 = __uint_as_float(w.w << 16), r7 = __uint_as_float(w.w & 0xffff0000u);
                    s1 += ((r0 + r1) + (r2 + r3)) + ((r4 + r5) + (r6 + r7)); s2 += ((r0 * r0 + r1 * r1) + (r2 * r2 + r3 * r3)) + ((r4 * r4 + r5 * r5) + (r6 * r6 + r7 * r7)); }
                s1 += __shfl_xor(s1, 16); s2 += __shfl_xor(s2, 16); s1 += __shfl_xor(s1, 32); s2 += __shfl_xor(s2, 32);
                if (fq == 0) { typedef float f32x2e __attribute__((ext_vector_type(2))); *(f32x2e*)(stats + ((size_t)row * 16 + u.pn * 4 + wc) * 2) = (f32x2e){s1, s2}; } }
    }
};
struct EpiMoe1 {
    static constexpr bool PERM = true, AFTER_DRAIN = false;
    bf16_t* Hh;
    __device__ __forceinline__ void operator()(const f32x4 (&acc)[2][2][4][2], const Unit& u, int wr, int wc, int fr, int fq) const {
        const int row0 = u.pm * BM + wr * 64 + fr, col0 = (u.pn & 3) * HALF + wc * 32 + 8 * fq;
#pragma unroll
        for (int ai = 0; ai < 2; ++ai)
#pragma unroll
            for (int m = 0; m < 4; ++m) { bf16_t* rowp = Hh + (size_t)(row0 + ai * HALF + m * 16) * 512 + col0;
                float h[8];
#pragma unroll
                for (int n = 0; n < 2; ++n)
#pragma unroll
                    for (int i = 0; i < 4; ++i) { const float a = acc[ai][0][m][n][i], b = acc[ai][1][m][n][i]; h[n * 4 + i] = a * b * __builtin_amdgcn_rcpf(1.f + __builtin_amdgcn_exp2f(-1.4426950408889634f * a)); }
                u32x4 w; w.x = cvt_pk_bf16(h[0], h[1]); w.y = cvt_pk_bf16(h[2], h[3]); w.z = cvt_pk_bf16(h[4], h[5]); w.w = cvt_pk_bf16(h[6], h[7]);
                *(u32x4*)rowp = w; }
    }
};
struct MoeOrder {
    const PG8_LAS int* tt; int ntiles, G, c;
    __device__ __forceinline__ void init(const PG8_LAS int* tt_, int G_, int c_) { tt = tt_; ntiles = __builtin_amdgcn_readfirstlane(tt_[511]); G = G_; c = c_; }
    __device__ __forceinline__ bool next(int i, Unit& u) const {
        const int L = i * G + c; if (L >= ntiles * 4) return false;
        const int pm = L >> 2; const int e = __builtin_amdgcn_readfirstlane(tt[pm]); u.pm = pm; u.pn = e * 4 + (L & 3); return true;
    }
    __device__ __forceinline__ void a_ready(const Unit&) const {}
    __device__ __forceinline__ void done(const Unit&) const {}
};
template <class Epi, class Sched, bool ALIGN_EPI = false, bool SP2 = false, bool GATHER = false>
__device__ __forceinline__ void gemm_phase(PG8_LAS unsigned char* lds, const Gemm g, const Sched& S, const Epi& E, const PG8_LAS unsigned* goff = nullptr) {
    static_assert(!GATHER || SP2, "gather is wired into the SP2 loop only");
    int tid_l = threadIdx.x; asm volatile("" : "+v"(tid_l));
    const int tid = tid_l, wid = __builtin_amdgcn_readfirstlane(tid >> 6), lane = tid & 63, wr = wid >> 2, wc = wid & 3, fr = lane & 15, fq = lane >> 4;
    const int K = g.K, nt = K / BK;
    unsigned voffA[2], voffB[2];
#pragma unroll
    for (int i = 0; i < 2; ++i) { int R, C; stage_rc(tid * 16 + i * 8192, R, C); const int Rb = Epi::PERM ? ((R & ~31) + perm32(R & 31)) : R;
        voffA[i] = (unsigned)(R * K + C) * 2u; voffB[i] = (unsigned)(Rb * K + C) * 2u; }
    int gRow[2]; unsigned gCol[2];
#pragma unroll
    for (int i = 0; i < 2; ++i) { int R, C; stage_rc(tid * 16 + i * 8192, R, C); gRow[i] = R; gCol[i] = (unsigned)C * 2u; }
    unsigned gA[2][2] = {{0u, 0u}, {0u, 0u}}, gAn[2][2] = {{0u, 0u}, {0u, 0u}};
#define PG8_GLOAD(dst, u_) do { _Pragma("unroll") for (int h_ = 0; h_ < 2; ++h_) _Pragma("unroll") for (int i_ = 0; i_ < 2; ++i_) dst[h_][i_] = goff[(u_) * 256 + h_ * 128 + gRow[i_]] + gCol[i_]; } while (0)
    const size_t kstep = (size_t)(BK * 2);
    const size_t hstep = (size_t)HALF * K * 2;
    const size_t tstep = 2 * hstep;
    const unsigned ldsw = (unsigned)wid * 1024u;
    const int aoff = lds_byte(wr * 64 + fr, fq * 8), boff = lds_byte(wc * 32 + fr, fq * 8);
#define PG8_SA(b, h) (((b) * 2 + (h)) * HTB)
#define PG8_SB(b, h) ((4 + (b) * 2 + (h)) * HTB)
#define PG8_STAGE(bufoff, gbase, voff) do { _Pragma("unroll") for (int _i = 0; _i < 2; ++_i) \
        __builtin_amdgcn_global_load_lds((const unsigned*)((const char*)(gbase) + (voff)[_i]), (PG8_LAS unsigned*)(lds + (bufoff) + ldsw + _i * 8192), 16, 0, 0); } while (0)
#define PG8_STAGE_A(bufoff, ptr, h, nx) do { if constexpr (GATHER) { unsigned vo_[2]; vo_[0] = (nx) ? gAn[h][0] : gA[h][0]; vo_[1] = (nx) ? gAn[h][1] : gA[h][1]; PG8_STAGE(bufoff, ptr, vo_); } \
        else PG8_STAGE(bufoff, (ptr) + (h) * hstep, voffA); } while (0)
#define PG8_LDA(dst, b, h) do { _Pragma("unroll") for (int m = 0; m < 4; ++m) _Pragma("unroll") for (int k = 0; k < 2; ++k) dst[m][k] = *(const PG8_LAS bf16x8*)(lds + PG8_SA(b, h) + aoff + m * 2048 + k * 1024); } while (0)
#define PG8_LDB(dst, b, h) do { _Pragma("unroll") for (int n = 0; n < 2; ++n) _Pragma("unroll") for (int k = 0; k < 2; ++k) dst[n][k] = *(const PG8_LAS bf16x8*)(lds + PG8_SB(b, h) + boff + n * 2048 + k * 1024); } while (0)
#define PG8_MMA(ai, bj, At, Bt) do { __builtin_amdgcn_s_setprio(1); _Pragma("unroll") for (int m = 0; m < 4; ++m) _Pragma("unroll") for (int n = 0; n < 2; ++n) _Pragma("unroll") for (int k = 0; k < 2; ++k) \
        acc[ai][bj][m][n] = __builtin_amdgcn_mfma_f32_16x16x32_bf16(Bt[n][k], At[m][k], acc[ai][bj][m][n], 0, 0, 0); __builtin_amdgcn_s_setprio(0); } while (0)
#define PG8_WAIT_V(n) asm volatile("s_waitcnt vmcnt(" #n ")" ::: "memory")
#define PG8_WAIT_L(n) asm volatile("s_waitcnt lgkmcnt(" #n ")" ::: "memory")
#define PG8_BAR __builtin_amdgcn_s_barrier()
#define PG8_SCHED __builtin_amdgcn_sched_barrier(0)
    Unit cur, nxt; int ui = 0;
    if (!S.next(0, cur)) return;
    f32x4 acc[2][2][4][2];
#pragma unroll
    for (int a = 0; a < 2; ++a)
#pragma unroll
        for (int b = 0; b < 2; ++b)
#pragma unroll
            for (int m = 0; m < 4; ++m)
#pragma unroll
                for (int n = 0; n < 2; ++n) acc[a][b][m][n] = (f32x4){0.f, 0.f, 0.f, 0.f};
    bf16x8 At[4][2], B0[2][2], B1[2][2];
    const char* cA = (const char*)g.A + (GATHER ? (size_t)0 : (size_t)cur.pm * tstep); const char* cB = (const char*)g.Bt + (size_t)cur.pn * tstep;
    if constexpr (GATHER) PG8_GLOAD(gA, 0);
    S.a_ready(cur);
    if constexpr (SP2) {
        PG8_STAGE(PG8_SB(0, 0), cB, voffB); PG8_STAGE(PG8_SB(0, 1), cB + hstep, voffB); PG8_STAGE_A(PG8_SA(0, 0), cA, 0, false); PG8_STAGE_A(PG8_SA(0, 1), cA, 1, false);
        if (wr == 1) PG8_BAR;
        PG8_WAIT_V(2); PG8_BAR;
        PG8_STAGE(PG8_SB(1, 0), cB + kstep, voffB); PG8_STAGE_A(PG8_SA(1, 0), cA + kstep, 0, false); PG8_STAGE(PG8_SB(1, 1), cB + hstep + kstep, voffB);
        PG8_WAIT_V(6); PG8_BAR;
    } else {
        PG8_STAGE(PG8_SB(0, 0), cB, voffB); PG8_STAGE(PG8_SA(0, 0), cA, voffA); PG8_STAGE(PG8_SB(0, 1), cB + hstep, voffB); PG8_STAGE(PG8_SA(0, 1), cA + hstep, voffA);
        if (wr == 1) PG8_BAR;
        PG8_WAIT_V(4); PG8_BAR;
        PG8_STAGE(PG8_SB(1, 0), cB + kstep, voffB); PG8_STAGE(PG8_SA(1, 0), cA + kstep, voffA); PG8_STAGE(PG8_SB(1, 1), cB + hstep + kstep, voffB);
        PG8_WAIT_V(6); PG8_BAR;
    }
    for (;;) {
        const bool has_next = S.next(ui + 1, nxt);
        if constexpr (GATHER) { if (has_next) PG8_GLOAD(gAn, ui + 1); }
        const char* nA = (has_next && !GATHER) ? (const char*)g.A + (size_t)nxt.pm * tstep : cA; const char* nB = has_next ? (const char*)g.Bt + (size_t)nxt.pn * tstep : cB;
        for (int t = 0; t < nt; t += 2) {
            const bool last = (t == nt - 2);
            const char* a1 = cA + (size_t)(t + 1) * kstep;
            const char* a2 = last ? nA : cA + (size_t)(t + 2) * kstep; const char* b2 = last ? nB : cB + (size_t)(t + 2) * kstep;
            const char* a3 = a2 + kstep; const char* b3 = b2 + kstep;
            if (last && has_next) S.a_ready(nxt);
            const bool nx = last && has_next;
            if constexpr (SP2) {
            PG8_LDB(B0, 0, 0); PG8_LDB(B1, 0, 1); PG8_SCHED; PG8_LDA(At, 0, 0); PG8_STAGE_A(PG8_SA(1, 1), a1, 1, false);
            PG8_WAIT_V(8); PG8_WAIT_L(0); PG8_BAR; PG8_MMA(0, 0, At, B0); PG8_MMA(0, 1, At, B1); PG8_BAR; PG8_SCHED;
            PG8_LDA(At, 0, 1); PG8_STAGE(PG8_SB(0, 0), b2, voffB); PG8_STAGE(PG8_SB(0, 1), b2 + hstep, voffB); PG8_STAGE_A(PG8_SA(0, 0), a2, 0, nx);
            PG8_WAIT_V(8); PG8_WAIT_L(0); PG8_BAR; PG8_MMA(1, 0, At, B0); PG8_MMA(1, 1, At, B1); PG8_BAR; PG8_SCHED;
            PG8_LDB(B0, 1, 0); PG8_LDB(B1, 1, 1); PG8_SCHED; PG8_LDA(At, 1, 0); PG8_STAGE_A(PG8_SA(0, 1), a2, 1, nx);
            PG8_WAIT_V(8); PG8_WAIT_L(0); PG8_BAR; PG8_MMA(0, 0, At, B0); PG8_MMA(0, 1, At, B1); PG8_BAR; PG8_SCHED;
            PG8_LDA(At, 1, 1); PG8_STAGE(PG8_SB(1, 0), b3, voffB); PG8_STAGE(PG8_SB(1, 1), b3 + hstep, voffB); PG8_STAGE_A(PG8_SA(1, 0), a3, 0, nx);
            PG8_WAIT_V(8); PG8_WAIT_L(0); PG8_BAR; PG8_MMA(1, 0, At, B0); PG8_MMA(1, 1, At, B1); PG8_BAR; PG8_SCHED;
            } else {
            PG8_LDB(B0, 0, 0); PG8_SCHED; PG8_LDA(At, 0, 0); PG8_STAGE(PG8_SA(1, 1), a1 + hstep, voffA);
            PG8_WAIT_L(8); PG8_BAR; PG8_WAIT_L(0); PG8_MMA(0, 0, At, B0); PG8_BAR; PG8_SCHED;
            PG8_LDB(B1, 0, 1); PG8_STAGE(PG8_SB(0, 0), b2, voffB);
            PG8_BAR; PG8_WAIT_L(0); PG8_MMA(0, 1, At, B1); PG8_BAR;
            PG8_LDA(At, 0, 1); PG8_STAGE(PG8_SA(0, 0), a2, voffA);
            PG8_BAR; PG8_WAIT_L(0); PG8_MMA(1, 0, At, B0); PG8_BAR; PG8_SCHED;
            PG8_STAGE(PG8_SB(0, 1), b2 + hstep, voffB);
            PG8_WAIT_V(6); PG8_BAR; PG8_MMA(1, 1, At, B1); PG8_BAR;
            PG8_LDB(B0, 1, 0); PG8_SCHED; PG8_LDA(At, 1, 0); PG8_STAGE(PG8_SA(0, 1), a2 + hstep, voffA);
            PG8_WAIT_L(8); PG8_BAR; PG8_WAIT_L(0); PG8_MMA(0, 0, At, B0); PG8_BAR; PG8_SCHED;
            PG8_LDB(B1, 1, 1); PG8_STAGE(PG8_SB(1, 0), b3, voffB);
            PG8_BAR; PG8_WAIT_L(0); PG8_MMA(0, 1, At, B1); PG8_BAR;
            PG8_LDA(At, 1, 1); PG8_STAGE(PG8_SA(1, 0), a3, voffA);
            PG8_BAR; PG8_WAIT_L(0); PG8_MMA(1, 0, At, B0); PG8_BAR; PG8_SCHED;
            PG8_STAGE(PG8_SB(1, 1), b3 + hstep, voffB);
            PG8_WAIT_V(6); PG8_BAR; PG8_MMA(1, 1, At, B1); PG8_BAR;
            }
        }
        if constexpr (ALIGN_EPI) { if (wr == 0) PG8_BAR; }
        if constexpr (!Epi::AFTER_DRAIN) { E(acc, cur, wr, wc, fr, fq); S.done(cur); }
        if (!has_next) break;
#pragma unroll
        for (int a = 0; a < 2; ++a)
#pragma unroll
            for (int b = 0; b < 2; ++b)
#pragma unroll
                for (int m = 0; m < 4; ++m)
#pragma unroll
                    for (int n = 0; n < 2; ++n) acc[a][b][m][n] = (f32x4){0.f, 0.f, 0.f, 0.f};
        cur = nxt; cA = nA; cB = nB; ++ui;
        if constexpr (GATHER) { _Pragma("unroll") for (int h_ = 0; h_ < 2; ++h_) _Pragma("unroll") for (int i_ = 0; i_ < 2; ++i_) gA[h_][i_] = gAn[h_][i_]; }
        if constexpr (ALIGN_EPI) { if (wr == 1) PG8_BAR; }
    }
    PG8_WAIT_V(0);
    if constexpr (!ALIGN_EPI) { if (wr == 0) PG8_BAR; }
    PG8_BAR;
    if constexpr (Epi::AFTER_DRAIN) { E.fused(acc, cur, wr, wc, fr, fq, lds, wid, lane); S.done(cur); }
#undef PG8_SA
#undef PG8_SB
#undef PG8_STAGE
#undef PG8_STAGE_A
#undef PG8_GLOAD
#undef PG8_LDA
#undef PG8_LDB
#undef PG8_MMA
#undef PG8_WAIT_V
#undef PG8_WAIT_L
#undef PG8_BAR
#undef PG8_SCHED
}
}
#define XB_TMO      128
#define XB_XCNT(j)  (256  + 64 * (j))
#define XB_XSUB(j)  (1280 + 64 * (j))
#define XB_XGEN(j)  (2304 + 64 * (j))
#define XB_TOP      3328
#define XB_TOPGEN   3392
#define XCD_BAR_WORDS 3456
#define XB_SPIN_CAP (1u << 18)

__device__ __forceinline__ unsigned xb_ld(unsigned* p)              { return __hip_atomic_load(p, __ATOMIC_RELAXED, __HIP_MEMORY_SCOPE_AGENT); }
__device__ __forceinline__ unsigned xb_add(unsigned* p, unsigned v) { return __hip_atomic_fetch_add(p, v, __ATOMIC_RELAXED, __HIP_MEMORY_SCOPE_AGENT); }
__device__ __forceinline__ unsigned xb_xcc_id() { return (unsigned)__builtin_amdgcn_s_getreg((3 << 11) | 20) & 0xFu; }
#define XB_SPIN(cond, bar) do { unsigned _sp = 0; while (cond) { __builtin_amdgcn_s_sleep(1); \
    if ((++_sp & 255u) == 0u) { if (xb_ld(&(bar)[XB_TMO])) break; if (_sp > XB_SPIN_CAP) { atomicAdd(&(bar)[XB_TMO], 1u); break; } } } } while (0)

struct XcdBarrier {
    unsigned* bar; unsigned x;
    volatile LAS unsigned* st;
};

__device__ __forceinline__ XcdBarrier xcd_barrier_post(unsigned* bar, volatile LAS unsigned* st) {
    XcdBarrier b; b.bar = bar; b.x = xb_xcc_id(); b.st = st;
    if (threadIdx.x == 0) (void)xb_add(&bar[XB_XCNT(b.x)], 1u);
    return b;
}
__device__ __forceinline__ void xcd_barrier_complete(unsigned* bar, unsigned x, unsigned& nloc, unsigned& nx) {
    const unsigned G = gridDim.x * gridDim.y * gridDim.z;
    unsigned sum, cnt, mine, sp = 0u;
    for (;;) {
        sum = 0u; cnt = 0u; mine = 0u;
#pragma unroll
        for (unsigned j = 0; j < 16; ++j) { const unsigned c = xb_ld(&bar[XB_XCNT(j)]); sum += c; cnt += (c > 0u) ? 1u : 0u; mine = (j == x) ? c : mine; }
        if (sum == G) break;
        __builtin_amdgcn_s_sleep(1);
        if ((++sp & 255u) == 0u) { if (xb_ld(&bar[XB_TMO])) break; if (sp > XB_SPIN_CAP) { atomicAdd(&bar[XB_TMO], 1u); break; } }
    }
    nloc = mine > 0u ? mine : 1u; nx = cnt > 0u ? cnt : 1u;
}

__device__ __forceinline__ void xcd_barrier(const XcdBarrier& b) {
    asm volatile("s_waitcnt vmcnt(0)" ::: "memory");
    __syncthreads();
    if (threadIdx.x == 0) {
        unsigned* bar = b.bar;
        __builtin_amdgcn_s_waitcnt(0);
        unsigned nloc = b.st[0], nx = b.st[1];
        if (nloc == 0u) { xcd_barrier_complete(bar, b.x, nloc, nx); b.st[0] = nloc; b.st[1] = nx; }
        const unsigned old = xb_add(&bar[XB_XSUB(b.x)], 1u);
        const unsigned gen = old / nloc;
        if (old + 1u == (gen + 1u) * nloc) {
            __builtin_amdgcn_fence(__ATOMIC_RELEASE, "agent");
            asm volatile("s_waitcnt vmcnt(0)" ::: "memory");
            const unsigned og = xb_add(&bar[XB_TOP], 1u);
            const unsigned tg = og / nx;
            if (og + 1u == (tg + 1u) * nx) xb_add(&bar[XB_TOPGEN], 1u);
            else XB_SPIN(xb_ld(&bar[XB_TOPGEN]) == tg, bar);
            __builtin_amdgcn_fence(__ATOMIC_ACQUIRE, "agent");
            xb_add(&bar[XB_XGEN(b.x)], 1u);
            asm volatile("s_waitcnt vmcnt(0)" ::: "memory");
        } else {
            XB_SPIN(xb_ld(&bar[XB_XGEN(b.x)]) == gen, bar);
            __builtin_amdgcn_fence(__ATOMIC_ACQUIRE, "agent");
            asm volatile("s_waitcnt vmcnt(0)" ::: "memory");
        }
    }
    __syncthreads();
}
constexpr int NWAVES = 8;
constexpr int RING_OFF = 0, RING_BYTES = 131072;
constexpr int LDSCTL_OFF = RING_BYTES, MISC_OFF = LDSCTL_OFF + 320;
constexpr int LDS_BYTES = 147456;
constexpr int TT_LDS_OFF = 132096;
constexpr int GOFF_LDS_OFF = TT_LDS_OFF + 4096, MOE_UMAX = 6;

struct Frame {
    LAS unsigned char* lds;
    volatile LAS unsigned* MISC;
    gu32* ctl;
    int tid, lane, wave, vcu, G;
};

__device__ __forceinline__ void transpose_item(const float* W, int N, bf16_t* WT, int K, int k0, int n0, int row0, float sc, LAS float* scr, int lane) {
    float v[32];
    const float* src = W + (size_t)(k0 + (lane >> 5)) * N + n0 + (lane & 31);
#pragma unroll
    for (int i = 0; i < 32; ++i) v[i] = __builtin_nontemporal_load(src + (size_t)(2 * i) * N);
#pragma unroll
    for (int i = 0; i < 32; ++i) scr[(2 * i + (lane >> 5)) * 33 + (lane & 31)] = v[i];
    LDS_WAIT(); asm volatile("" ::: "memory");
    const int c = lane & 7;
#pragma unroll
    for (int j = 0; j < 4; ++j) { const int n = (lane >> 3) + 8 * j; const LAS float* s = scr + (8 * c) * 33 + n;
        v4u o; o.x = cvtpk_c(s[0 * 33] * sc, s[1 * 33] * sc); o.y = cvtpk_c(s[2 * 33] * sc, s[3 * 33] * sc); o.z = cvtpk_c(s[4 * 33] * sc, s[5 * 33] * sc); o.w = cvtpk_c(s[6 * 33] * sc, s[7 * 33] * sc);
        *(GAS v4u*)(WT + (size_t)(row0 + n) * K + k0 + 8 * c) = o; }
    LDS_WAIT(); asm volatile("" ::: "memory");
}

struct Args {
    const float* in[25]; float* out; unsigned char* ws; int ph_lo, ph_hi;
};

__device__ __forceinline__ void moe_item(const Args& a, unsigned char* ws, int r, LAS float* scr, int lane) {
    constexpr int I_W1 = 16 * 16, I_W2 = 8 * 32;
    const int le = r / (2 * I_W1 + I_W2); int q = r % (2 * I_W1 + I_W2);
    if (q < 2 * I_W1) { const int which = q / I_W1; q %= I_W1; const int nb = q % 16, kb = q / 16, n0 = nb * 32;
        const float* W = a.in[which ? 23 : 22] + (size_t)le * D * FF;
        const int row0 = 256 * (n0 / 128) + 128 * which + (n0 % 128);
        transpose_item(W, FF, (bf16_t*)(ws + WS_W13) + (size_t)le * 1024 * 1024, D, kb * 64, n0, row0, 1.f, scr, lane); }
    else { q -= 2 * I_W1; const int nb = q % 32, kb = q / 32, n0 = nb * 32;
        transpose_item(a.in[24] + (size_t)le * FF * D, D, (bf16_t*)(ws + WS_W2) + (size_t)le * 1024 * 512, FF, kb * 64, n0, n0, 1.f, scr, lane); }
}
constexpr int BG_ITEMS = NEXP * 768, BG_CHUNKS = BG_ITEMS / 8;
__device__ __forceinline__ void bg_pump(Frame& F, const Args& a, const int seam) {
    unsigned char* ws = a.ws;
    LAS float* scr = (LAS float*)(F.lds + RING_OFF + F.wave * 16384);
    LAS int* w = (LAS int*)(F.lds + TT_LDS_OFF + 2048);
    gu32* head = F.ctl + CW_BGQ; gu32* done = F.ctl + CW_BGDONE + 64 * (seam < 0 ? 0 : seam);
    __syncthreads();
    if (F.tid == 0) { int go = 1;
        if (seam >= 0) { const unsigned d = __hip_atomic_fetch_add(done, 1u, RLX_AGENT); if (d + 1u >= (unsigned)F.G) go = 0; }
        w[0] = go ? (int)__hip_atomic_fetch_add(head, 1u, RLX_AGENT) : BG_CHUNKS; }
    __syncthreads();
    for (;;) {
        const int q = w[0];
        __syncthreads();
        if (q >= BG_CHUNKS) break;
        moe_item(a, ws, NEXP * 768 + q * 8 + F.wave, scr, F.lane);
        if (F.tid == 0) { int go = 1;
            if (seam >= 0 && __hip_atomic_load(done, RLX_AGENT) >= (unsigned)F.G) go = 0;
            w[0] = go ? (int)__hip_atomic_fetch_add(head, 1u, RLX_AGENT) : BG_CHUNKS; }
        __syncthreads();
    }
}
enum { PH_PRO_A = 0, PH_PRO_B, PH_L0_PROJ, PH_L0_MIXA, PH_L0_SCAN, PH_L0_MIXB, PH_L0_OUT, PH_L0_LNR, PH_L0_DISP, PH_L0_MOE1, PH_L0_MOE2, PH_L0_COMB,
       PH_L1_PROJ, PH_L1_ATT, PH_L1_OUT, PH_L1_LNR, PH_L1_DISP, PH_L1_MOE1, PH_L1_MOE2, PH_L1_COMB, PH_END };

__device__ __forceinline__ void phase_pro_a(Frame& F, const Args& a) {
    unsigned char* ws = a.ws;
    LAS float* scr = (LAS float*)(F.lds + RING_OFF + F.wave * 16384);
    const int gw = F.vcu * NWAVES + F.wave, NGW = F.G * NWAVES;
    constexpr int I_IN0 = 16 * (EVEN_IN / 32), I_IN1 = 16 * (ODD_IN / 32), I_OUT = 16 * 32, I_W1 = 16 * 16, I_W2 = 8 * 32;
    constexpr int I_MOE = 1 * NEXP * (2 * I_W1 + I_W2);
    constexpr int NITEMS = I_IN0 + I_IN1 + 2 * I_OUT + I_MOE;
    for (int it = gw; it < NITEMS; it += NGW) {
        int r = it;
        if (r < I_IN0) { const int nb = r % (EVEN_IN / 32), kb = r / (EVEN_IN / 32), n0 = nb * 32;
            const float sc = (n0 < 512) ? 0.125f * LOG2E : ((n0 >= P0_RK && n0 < P0_RV) ? 0.08838834764831845f : 1.f);
            transpose_item(a.in[8], EVEN_IN, (bf16_t*)(ws + WS_WIN0), D, kb * 64, n0, n0, sc, scr, F.lane); continue; } r -= I_IN0;
        if (r < I_IN1) { const int nb = r % (ODD_IN / 32), kb = r / (ODD_IN / 32), n0 = nb * 32;
            const float sc = (n0 < 1024) ? 0.125f * LOG2E : 1.f;
            transpose_item(a.in[11], ODD_IN, (bf16_t*)(ws + WS_WIN1), D, kb * 64, n0, n0, sc, scr, F.lane); continue; } r -= I_IN1;
        if (r < I_OUT) { const int nb = r % 32, kb = r / 32; transpose_item(a.in[9], D, (bf16_t*)(ws + WS_WOUT0), D, kb * 64, nb * 32, nb * 32, 1.f, scr, F.lane); continue; } r -= I_OUT;
        if (r < I_OUT) { const int nb = r % 32, kb = r / 32; transpose_item(a.in[12], D, (bf16_t*)(ws + WS_WOUT1), D, kb * 64, nb * 32, nb * 32, 1.f, scr, F.lane); continue; } r -= I_OUT;
        moe_item(a, ws, r, scr, F.lane);
    }
    float* modp = (float*)(ws + WS_MODP);
    for (int task = gw; task < 8 * 2 * 96; task += NGW) {
        const int ks = task / 192, l = (task / 96) % 2, n = (task % 96) * 64 + F.lane;
        const float* w = a.in[6] + ((size_t)l * D + ks * 128) * 6 * D + n; const float* c = a.in[1] + ks * 128;
        float a0 = 0, a1 = 0, a2 = 0, a3 = 0;
#pragma unroll 8
        for (int k = 0; k < 128; ++k) { const float wv = w[(size_t)k * 6 * D];
            a0 += silu_f(c[k]) * wv; a1 += silu_f(c[D + k]) * wv; a2 += silu_f(c[2 * D + k]) * wv; a3 += silu_f(c[3 * D + k]) * wv; }
        float* o = modp + ((size_t)(ks * 2 + l) * 4) * 6 * D + n;
        o[0] = a0; o[6 * D] = a1; o[2 * 6 * D] = a2; o[3 * 6 * D] = a3;
    }
    bf16_t* WrH = (bf16_t*)(ws + WS_WRT); bf16_t* WrL = WrH + DEPTH * 48 * D;
    for (int i = (F.vcu * NWAVES * 64 + F.tid); i < DEPTH * 48 * D; i += F.G * NWAVES * 64) {
        const int l = i / (48 * D), n = (i / D) % 48, k = i % D;
        const float w = (n < 4) ? a.in[18][((size_t)l * D + k) * 4 + n] : (n < 36 ? a.in[20][((size_t)l * D + k) * 32 + (n - 4)] : 0.f);
        const unsigned h = f2bf(w); WrH[i] = (bf16_t)h; WrL[i] = (bf16_t)f2bf(w - __uint_as_float(h << 16));
    }
}

__device__ __forceinline__ void phase_pro_b(Frame& F, const Args& a) {
    unsigned char* ws = a.ws;
    const float* modp = (const float*)(ws + WS_MODP); float* mod = (float*)(ws + WS_MOD);
    for (int i = F.vcu * NWAVES * 64 + F.tid; i < 2 * 4 * 6 * D; i += F.G * NWAVES * 64) {
        const int l = i / (4 * 6 * D), n = i % (6 * D);
        float s = a.in[7][l * 6 * D + n];
#pragma unroll
        for (int ks = 0; ks < 8; ++ks) s += modp[(size_t)ks * 2 * 4 * 6 * D + i];
        mod[i] = s;
    }
    LAS float* ms = (LAS float*)(F.lds + RING_OFF);
    for (int i = F.tid; i < 4 * 2 * D; i += NWAVES * 64) {
        const int b = i / (2 * D), n = i % (2 * D);
        float s = a.in[7][n];
#pragma unroll
        for (int ks = 0; ks < 8; ++ks) s += modp[((size_t)(ks * 2 + 0) * 4 + b) * 6 * D + n];
        ms[i] = s;
    }
    __syncthreads();
    const int gw = F.vcu * NWAVES + F.wave, NGW = F.G * NWAVES;
    bf16_t* U = (bf16_t*)(ws + WS_U); bf16_t* XB = (bf16_t*)a.out + (size_t)T * D;
    for (int blk = gw; blk < T / 16; blk += NGW) {
        const int row0 = blk * 16, b = row0 / SEQ;
        f32x4 ksh[4], ksc[4];
#pragma unroll
        for (int j = 0; j < 4; ++j) { const int c = 4 * F.lane + 256 * j; ksh[j] = *(const LAS f32x4*)(ms + b * 2 * D + c); ksc[j] = *(const LAS f32x4*)(ms + b * 2 * D + D + c) + 1.0f; }
#pragma unroll 4
        for (int i = 0; i < 16; ++i) { const int row = row0 + i; const GAS f32x4* xr = (const GAS f32x4*)(a.in[0] + (size_t)row * D) + F.lane;
#pragma unroll
            for (int j = 0; j < 4; ++j) { const f32x4 v = __builtin_nontemporal_load(xr + 64 * j); const f32x4 u = v * ksc[j] + ksh[j];
                ((GAS unsigned long long*)(U + (size_t)row * D))[F.lane + 64 * j] = (unsigned long long)cvtpk_c(u.x, u.y) | ((unsigned long long)cvtpk_c(u.z, u.w) << 32);
                ((GAS unsigned long long*)(XB + (size_t)row * D))[F.lane + 64 * j] = (unsigned long long)cvtpk_c(v.x, v.y) | ((unsigned long long)cvtpk_c(v.z, v.w) << 32); } }
    }
    __syncthreads();
}
__device__ __forceinline__ int opaque_i(int v) { asm volatile("" : "+v"(v)); return v; }

__device__ __forceinline__ void phase_lnr(Frame& F, const Args& a, const int l, const bool dry = false) {
    unsigned char* ws = a.ws; const bf16_t* Yb = (const bf16_t*)(ws + WS_Y); bf16_t* U2 = (bf16_t*)(ws + WS_U2); int* inv = (int*)(ws + WS_INV);
    const float* mod = (const float*)(ws + WS_MOD); const float* stats = (const float*)(ws + WS_STATS);
    int* tok_e = (int*)(ws + (dry ? WS_KN + 256 * 1024 : WS_ROUTE + RT_TOKE)); float* tok_g = (float*)(ws + (dry ? WS_KN + 512 * 1024 : WS_ROUTE + RT_TOKG)); int* tok_rank = (int*)(ws + (dry ? WS_KN + 768 * 1024 : WS_ROUTE + RT_RANK));
    unsigned* cnt = (unsigned*)(ws + WS_CTL) + (dry ? CW_CNT + 2 * 32 * 64 : CW_CNT + l * 32 * 64);
    const float* lng = a.in[2] + l * D; const float* lnb = a.in[3] + l * D; const float* bgrp = a.in[19] + l * 4; const float* brt = a.in[21] + l * 32;
    const bf16_t* WrH = (const bf16_t*)(ws + WS_WRT) + (size_t)l * 48 * D; const bf16_t* WrL = WrH + DEPTH * 48 * D;
    const int tid = opaque_i(F.tid), lane = tid & 63, wave = F.wave, r = lane & 15, kg = lane >> 4;
    LAS unsigned char* lds = F.lds + RING_OFF;
    LAS float* LG = (LAS float*)lds + wave * (16 * 49);
    LAS unsigned* hist = (LAS unsigned*)(lds + 32768);
    LAS int* pend = (LAS int*)(lds + 32768 + 256);
    LAS float* coef = (LAS float*)(lds + 40960);
    typedef float f32x4m __attribute__((ext_vector_type(4)));
    for (int tile = F.vcu; tile < T / 128; tile += F.G) {
        const int row0 = tile * 128 + wave * 16, row = row0 + r, b = row0 / SEQ;
        const float* m = mod + (size_t)(l * 4 + b) * 6 * D;
        if (tid < 64) hist[tid] = 0u;
        for (int i = tid; i < 1024; i += NWAVES * 64) { coef[i] = lng[i]; coef[1024 + i] = lnb[i]; coef[2048 + i] = 1.0f + m[4 * D + i]; coef[3072 + i] = m[3 * D + i]; }
        float mean, rstd;
        { typedef float f32x2e __attribute__((ext_vector_type(2))); const f32x2e* sp = (const f32x2e*)(stats + ((size_t)row * 16 + kg * 4) * 2);
          float s1 = (sp[0].x + sp[1].x) + (sp[2].x + sp[3].x), s2 = (sp[0].y + sp[1].y) + (sp[2].y + sp[3].y);
          s1 += __shfl_xor(s1, 16); s2 += __shfl_xor(s2, 16); s1 += __shfl_xor(s1, 32); s2 += __shfl_xor(s2, 32);
          mean = s1 * (1.f / D); rstd = rsqrtf(fmaxf(s2 * (1.f / D) - mean * mean, 0.f) + LN_EPS); }
        const bf16_t* yrow = Yb + (size_t)row * D + 8 * kg; bf16_t* u2row = U2 + (size_t)row * D + 8 * kg;
        const bf16_t* wh = WrH + (size_t)r * D + 8 * kg; const bf16_t* wl = WrL + (size_t)r * D + 8 * kg;
        f32x4m acc0 = {0.f, 0.f, 0.f, 0.f}, acc1 = acc0, acc2 = acc0;
        __syncthreads();
#pragma unroll 8
        for (int c = 0; c < 32; ++c) {
            const int k = c * 32;
            const v4u yv = *(const GAS v4u*)(yrow + k);
            const f32x4 y0 = {__uint_as_float(yv.x << 16), __uint_as_float(yv.x & 0xffff0000u), __uint_as_float(yv.y << 16), __uint_as_float(yv.y & 0xffff0000u)}, y1 = {__uint_as_float(yv.z << 16), __uint_as_float(yv.z & 0xffff0000u), __uint_as_float(yv.w << 16), __uint_as_float(yv.w & 0xffff0000u)};
            const int kc = k + 8 * kg;
            const f32x4 g0 = *(const LAS f32x4*)(coef + kc), g1 = *(const LAS f32x4*)(coef + kc + 4), b0 = *(const LAS f32x4*)(coef + 1024 + kc), b1 = *(const LAS f32x4*)(coef + 1024 + kc + 4);
            const f32x4 c0 = *(const LAS f32x4*)(coef + 2048 + kc), c1 = *(const LAS f32x4*)(coef + 2048 + kc + 4), h0 = *(const LAS f32x4*)(coef + 3072 + kc), h1 = *(const LAS f32x4*)(coef + 3072 + kc + 4);
            const f32x4 x0 = (y0 - mean) * rstd * g0 + b0, x1 = (y1 - mean) * rstd * g1 + b1;
            const f32x4 u0 = x0 * c0 + h0, u1 = x1 * c1 + h1;
            v4u uh; uh.x = cvtpk_c(u0.x, u0.y); uh.y = cvtpk_c(u0.z, u0.w); uh.z = cvtpk_c(u1.x, u1.y); uh.w = cvtpk_c(u1.z, u1.w);
            v4u ul;
            ul.x = cvtpk_c(u0.x - __uint_as_float(uh.x << 16), u0.y - __uint_as_float(uh.x & 0xffff0000u)); ul.y = cvtpk_c(u0.z - __uint_as_float(uh.y << 16), u0.w - __uint_as_float(uh.y & 0xffff0000u));
            ul.z = cvtpk_c(u1.x - __uint_as_float(uh.z << 16), u1.y - __uint_as_float(uh.z & 0xffff0000u)); ul.w = cvtpk_c(u1.z - __uint_as_float(uh.w << 16), u1.w - __uint_as_float(uh.w & 0xffff0000u));
            *(GAS v4u*)(u2row + k) = uh;
            const bf16x8 ah = __builtin_bit_cast(bf16x8, uh), al = __builtin_bit_cast(bf16x8, ul);
            const bf16x8 bh0 = *(const GAS bf16x8*)(wh + k), bh1 = *(const GAS bf16x8*)(wh + 16 * D + k), bh2 = *(const GAS bf16x8*)(wh + 32 * D + k);
            acc0 = __builtin_amdgcn_mfma_f32_16x16x32_bf16(ah, bh0, acc0, 0, 0, 0); acc0 = __builtin_amdgcn_mfma_f32_16x16x32_bf16(al, bh0, acc0, 0, 0, 0);
            acc1 = __builtin_amdgcn_mfma_f32_16x16x32_bf16(ah, bh1, acc1, 0, 0, 0); acc1 = __builtin_amdgcn_mfma_f32_16x16x32_bf16(al, bh1, acc1, 0, 0, 0);
            acc2 = __builtin_amdgcn_mfma_f32_16x16x32_bf16(ah, bh2, acc2, 0, 0, 0); acc2 = __builtin_amdgcn_mfma_f32_16x16x32_bf16(al, bh2, acc2, 0, 0, 0);
        }
#pragma unroll
        for (int i = 0; i < 4; ++i) { LG[(4 * kg + i) * 49 + r] = acc0[i]; LG[(4 * kg + i) * 49 + 16 + r] = acc1[i]; LG[(4 * kg + i) * 49 + 32 + r] = acc2[i]; }
        LDS_WAIT();
        if (lane < 16) {
            float lg[36];
#pragma unroll
            for (int n = 0; n < 36; ++n) lg[n] = LG[lane * 49 + n] + (n < 4 ? bgrp[n] : brt[n - 4]);
            int grp = 0; float gm = lg[0];
#pragma unroll
            for (int i = 1; i < 4; ++i) if (lg[i] > gm) { gm = lg[i]; grp = i; }
            float se = 0.f;
#pragma unroll
            for (int i = 0; i < 4; ++i) se += __expf(lg[i] - gm);
            const float pg = 1.f / se;
            float ev[8];
#pragma unroll
            for (int i = 0; i < 8; ++i) ev[i] = grp == 0 ? lg[4 + i] : (grp == 1 ? lg[12 + i] : (grp == 2 ? lg[20 + i] : lg[28 + i]));
            int i1 = 0; float v1 = ev[0];
#pragma unroll
            for (int i = 1; i < 8; ++i) if (ev[i] > v1) { v1 = ev[i]; i1 = i; }
            int i2 = -1; float v2 = -3.0e38f;
#pragma unroll
            for (int i = 0; i < 8; ++i) if (i != i1 && ev[i] > v2) { v2 = ev[i]; i2 = i; }
            const float e2 = __expf(v2 - v1), g1 = pg / (1.f + e2), g2 = pg * e2 / (1.f + e2);
            const int ea = grp * 8 + i1, eb = grp * 8 + i2, rw = row0 + lane;
            tok_e[rw * 2] = ea; tok_e[rw * 2 + 1] = eb; tok_g[rw * 2] = g1; tok_g[rw * 2 + 1] = g2;
            const int ra = (int)__hip_atomic_fetch_add(&hist[ea], 1u, __ATOMIC_RELAXED, __HIP_MEMORY_SCOPE_WORKGROUP), rb = (int)__hip_atomic_fetch_add(&hist[eb], 1u, __ATOMIC_RELAXED, __HIP_MEMORY_SCOPE_WORKGROUP);
            LAS int* pe = pend + (wave * 16 + lane) * 4; pe[0] = ea; pe[1] = eb; pe[2] = ra; pe[3] = rb;
        }
        __syncthreads();
        if (tid < 32) { const unsigned n = hist[tid]; hist[32 + tid] = n ? atomicAdd(cnt + tid * 64, n) : 0u; }
        __syncthreads();
        if (tid < 128) { const LAS int* pe = pend + tid * 4; const int rw = tile * 128 + tid; const int ra = (int)hist[32 + pe[0]] + pe[2], rb = (int)hist[32 + pe[1]] + pe[3];
            tok_rank[rw * 2] = ra; tok_rank[rw * 2 + 1] = rb; inv[pe[0] * 65536 + ra] = rw; inv[pe[1] * 65536 + rb] = rw; }
        __syncthreads();
    }
}

__device__ __forceinline__ void moe_tables(Frame& F, const Args& a, const int l, const bool tiles, const bool gather) {
    unsigned char* ws = a.ws; const unsigned* cnt = (const unsigned*)(ws + WS_CTL) + CW_CNT + l * 32 * 64;
    LAS int* ttl = (LAS int*)(F.lds + TT_LDS_OFF); LAS int* pstart = ttl + 320; LAS int* pcnt = ttl + 360;
    const int tid = opaque_i(F.tid);
    __syncthreads();
    if (tid < 64) {
        const int e = tid & 31; const int c = (int)__hip_atomic_load(cnt + e * 64, RLX_AGENT); const int pad = (c + 255) / 256 * 256;
        int run = pad;
#pragma unroll
        for (int o = 1; o < 32; o <<= 1) { const int t = __shfl_up(run, o, 32); if (e >= o) run += t; }
        const int ps = run - pad;
        if (tid < 32) { pcnt[e] = c; pstart[e] = ps; if (e == 31) { pstart[32] = run; ttl[511] = run >> 8; }
            if (tiles) { for (int t = ps >> 8; t < (run >> 8); ++t) ttl[t] = e; } }
    }
    __syncthreads();
    if (gather) {
        LAS unsigned* goff = (LAS unsigned*)(F.lds + GOFF_LDS_OFF); const int* inv = (const int*)(ws + WS_INV);
        const int nu = ttl[511] * 4;
#pragma unroll
        for (int it = 0; it < MOE_UMAX * 256 / (NWAVES * 64); ++it) { const int s = tid + it * NWAVES * 64; const int i = s >> 8, r = s & 255, L = i * F.G + F.vcu; unsigned off = (unsigned)WS_ZROW;
            if (L < nu) { const int pm = L >> 2, e = ttl[pm], rank = pm * 256 - pstart[e] + r; if (rank < pcnt[e]) off = (unsigned)WS_U2 + (unsigned)inv[e * 65536 + rank] * 2048u; }
            goff[s] = off; }
        __syncthreads();
    }
}

__device__ __forceinline__ void phase_comb(Frame& F, const Args& a, const int l) {
    unsigned char* ws = a.ws;
    const float* mod = (const float*)(ws + WS_MOD); const bf16_t* Y = (const bf16_t*)(ws + WS_XS); bf16_t* Unext = (bf16_t*)(ws + WS_U); const bf16_t* X1 = (const bf16_t*)(ws + WS_Y);
    const int* tok_e = (const int*)(ws + WS_ROUTE + RT_TOKE); const int* tok_rank = (const int*)(ws + WS_ROUTE + RT_RANK); const float* tok_g = (const float*)(ws + WS_ROUTE + RT_TOKG);
    moe_tables(F, a, l, false, false); const LAS int* pstart = (const LAS int*)(F.lds + TT_LDS_OFF) + 320;
    const float* lng = a.in[4] + l * D; const float* lnb = a.in[5] + l * D; const float* lng1 = a.in[2] + l * D; const float* lnb1 = a.in[3] + l * D;
    const int lane = opaque_i(F.lane);
    const int gw = F.vcu * NWAVES + F.wave, NGW = F.G * NWAVES;
    for (int blk = gw; blk < T / 16; blk += NGW) {
        const int row0 = blk * 16, b = row0 / SEQ;
        const float* m = mod + (size_t)(l * 4 + b) * 6 * D; const float* mn = mod + (size_t)((l + 1) * 4 + b) * 6 * D;
        const int myslot = pstart[tok_e[row0 * 2 + (lane & 31)]] + tok_rank[row0 * 2 + (lane & 31)]; const float mygate = tok_g[row0 * 2 + (lane & 31)];
        f32x4 kg2[4], kln[4], klb[4], ksc[4], ksh[4], kl1[4], kb1[4];
#pragma unroll
        for (int j = 0; j < 4; ++j) { const int c = 4 * lane + 256 * j; kg2[j] = *(const f32x4*)(m + 5 * D + c) + 1.0f; kln[j] = *(const f32x4*)(lng + c); klb[j] = *(const f32x4*)(lnb + c); kl1[j] = *(const f32x4*)(lng1 + c); kb1[j] = *(const f32x4*)(lnb1 + c);
            if (l == 0) { ksc[j] = *(const f32x4*)(mn + 1 * D + c) + 1.0f; ksh[j] = *(const f32x4*)(mn + 0 * D + c); } else { ksc[j] = kg2[j]; ksh[j] = kg2[j]; } }
        v2u nx[4], np[4], nq[4];
#define COMB_LOAD(i_) do { const int sa_ = __shfl(myslot, 2 * (i_)), sb_ = __shfl(myslot, 2 * (i_) + 1); \
            const GAS v2u* xr_ = (const GAS v2u*)(X1 + (size_t)(row0 + (i_)) * D) + lane; const GAS v2u* ya_ = (const GAS v2u*)(Y + (size_t)sa_ * D) + lane; const GAS v2u* yb_ = (const GAS v2u*)(Y + (size_t)sb_ * D) + lane; \
            _Pragma("unroll") for (int j = 0; j < 4; ++j) { nx[j] = xr_[64 * j]; np[j] = ya_[64 * j]; nq[j] = yb_[64 * j]; } } while (0)
        COMB_LOAD(0);
        for (int i = 0; i < 16; ++i) {
            v2u cx[4], cp[4], cq[4];
#pragma unroll
            for (int j = 0; j < 4; ++j) { cx[j] = nx[j]; cp[j] = np[j]; cq[j] = nq[j]; }
            const float ga = __shfl(mygate, 2 * i), gb = __shfl(mygate, 2 * i + 1);
            if (i < 15) COMB_LOAD(i + 1);
            const int row = row0 + i;
            f32x4 v[4]; float s = 0.f;
            float ys = 0.f, yq = 0.f;
#pragma unroll
            for (int j = 0; j < 4; ++j) { const v2u xw = cx[j]; const float y0 = __uint_as_float(xw.x << 16), y1 = __uint_as_float(xw.x & 0xffff0000u), y2 = __uint_as_float(xw.y << 16), y3 = __uint_as_float(xw.y & 0xffff0000u);
                ys += (y0 + y1) + (y2 + y3); yq += (y0 * y0 + y1 * y1) + (y2 * y2 + y3 * y3); }
            const float mean1 = wave_sum(ys) * (1.f / D), rstd1 = rsqrtf(fmaxf(wave_sum(yq) * (1.f / D) - mean1 * mean1, 0.f) + LN_EPS);
#pragma unroll
            for (int j = 0; j < 4; ++j) {
                const v2u xw = cx[j], p = cp[j], q = cq[j]; const f32x4 g2 = kg2[j];
                const f32x4 yv = {__uint_as_float(xw.x << 16), __uint_as_float(xw.x & 0xffff0000u), __uint_as_float(xw.y << 16), __uint_as_float(xw.y & 0xffff0000u)};
                const f32x4 x1 = (yv - mean1) * rstd1 * kl1[j] + kb1[j];
                f32x4 f;
                f.x = ga * __uint_as_float(p.x << 16) + gb * __uint_as_float(q.x << 16); f.y = ga * __uint_as_float(p.x & 0xffff0000u) + gb * __uint_as_float(q.x & 0xffff0000u);
                f.z = ga * __uint_as_float(p.y << 16) + gb * __uint_as_float(q.y << 16); f.w = ga * __uint_as_float(p.y & 0xffff0000u) + gb * __uint_as_float(q.y & 0xffff0000u);
                v[j] = x1 * ALPHA + g2 * f;
                s += (v[j].x + v[j].y) + (v[j].z + v[j].w);
            }
            const float mean = wave_sum(s) * (1.f / D); float s2 = 0.f;
#pragma unroll
            for (int j = 0; j < 4; ++j) { v[j] = v[j] - mean; s2 += (v[j].x * v[j].x + v[j].y * v[j].y) + (v[j].z * v[j].z + v[j].w * v[j].w); }
            const float rstd = rsqrtf(wave_sum(s2) * (1.f / D) + LN_EPS);
#pragma unroll
            for (int j = 0; j < 4; ++j) {
                const f32x4 x2 = v[j] * rstd * kln[j] + klb[j];
                if (l == 0) {
                    const f32x4 u = x2 * ksc[j] + ksh[j];
                    v2u xw; xw.x = cvtpk_c(x2.x, x2.y); xw.y = cvtpk_c(x2.z, x2.w); ((GAS v2u*)((bf16_t*)a.out + (size_t)row * D))[lane + 64 * j] = xw;
                    v2u uw; uw.x = cvtpk_c(u.x, u.y); uw.y = cvtpk_c(u.z, u.w); ((GAS v2u*)(Unext + (size_t)row * D))[lane + 64 * j] = uw;
                } else ((GAS f32x4*)(a.out + (size_t)row * D))[lane + 64 * j] = x2;
            }
        }
#undef COMB_LOAD
    }
}

typedef short v4i16_t __attribute__((ext_vector_type(4)));
__device__ __forceinline__ int crow(int r, int hi) { return (r & 3) + 8 * (r >> 2) + 4 * hi; }
__device__ __forceinline__ unsigned cvtpk(float lo, float hi) { unsigned r; asm("v_cvt_pk_bf16_f32 %0, %1, %2" : "=v"(r) : "v"(lo), "v"(hi)); return r; }
#define MFMA32(a, b, c) __builtin_amdgcn_mfma_f32_32x32x16_bf16((a), (b), (c), 0, 0, 0)
constexpr int KCH = 1040;

template <int NCH> __device__ __forceinline__ void ktile_load(v4u (&reg)[NCH / 8], const bf16_t* gsrc, int pitch, int tid) {
#pragma unroll
    for (int i = 0; i < NCH / 8; ++i) { const int item = tid + 512 * i, row = item / NCH, c = item % NCH; reg[i] = *(const GAS v4u*)(gsrc + (size_t)row * pitch + c * 8); }
}
template <int NCH> __device__ __forceinline__ void ktile_store(const v4u (&reg)[NCH / 8], LAS unsigned char* dst, int tid) {
#pragma unroll
    for (int i = 0; i < NCH / 8; ++i) { const int item = tid + 512 * i, row = item / NCH, c = item % NCH; *(LAS v4u*)(dst + c * KCH + row * 16) = reg[i]; }
}
__device__ __forceinline__ bf16x8 kfrag(const LAS unsigned char* tile, int blk, int step, int r32, int hi) {
    return *(const LAS bf16x8*)(tile + (step * 2 + hi) * KCH + (blk * 32 + r32) * 16);
}
template <int NDB> __device__ __forceinline__ void vtile_load(v4u (&reg)[NDB / 2], const bf16_t* gsrc, int pitch, int tid) {
#pragma unroll
    for (int i = 0; i < NDB / 2; ++i) { const int item = tid + 512 * i, row = item / (NDB * 4), c = item % (NDB * 4); reg[i] = *(const GAS v4u*)(gsrc + (size_t)row * pitch + c * 8); }
}
template <int NDB> __device__ __forceinline__ void vtile_store(const v4u (&reg)[NDB / 2], LAS unsigned char* dst, int tid) {
#pragma unroll
    for (int i = 0; i < NDB / 2; ++i) { const int item = tid + 512 * i, row = item / (NDB * 4), c = item % (NDB * 4);
        *(LAS v4u*)(dst + ((c >> 2) * 4 + (row >> 4)) * 1024 + (row & 15) * 64 + (c & 3) * 16) = reg[i]; }
}
__device__ __forceinline__ int vfrag_lane_off(int lane) { return ((lane >> 4) & 1) * 32 + (lane & 3) * 8 + (4 * (lane >> 5) + ((lane & 15) >> 2)) * 64; }
__device__ __forceinline__ bf16x8 vfrag(const LAS unsigned char* tile, int db, int s, int laneoff) {
    const LAS unsigned char* p = tile + (db * 4 + s) * 1024 + laneoff;
    const s16x4 lo = __builtin_bit_cast(s16x4, __builtin_amdgcn_ds_read_tr16_b64_v4i16((LAS v4i16_t*)p));
    const s16x4 hi = __builtin_bit_cast(s16x4, __builtin_amdgcn_ds_read_tr16_b64_v4i16((LAS v4i16_t*)(p + 512)));
    return (bf16x8){lo[0], lo[1], lo[2], lo[3], hi[0], hi[1], hi[2], hi[3]};
}
__device__ __forceinline__ int vfragn_lane_off(int lane) { return ((lane >> 4) & 1) * 32 + (lane & 3) * 8 + (8 * (lane >> 5) + ((lane & 15) >> 2)) * 64; }
__device__ __forceinline__ bf16x8 vfragn(const LAS unsigned char* tile, int db, int s, int laneoff) {
    const LAS unsigned char* p = tile + (db * 4 + s) * 1024 + laneoff;
    const s16x4 lo = __builtin_bit_cast(s16x4, __builtin_amdgcn_ds_read_tr16_b64_v4i16((LAS v4i16_t*)p));
    const s16x4 hi = __builtin_bit_cast(s16x4, __builtin_amdgcn_ds_read_tr16_b64_v4i16((LAS v4i16_t*)(p + 256)));
    return (bf16x8){lo[0], lo[1], lo[2], lo[3], hi[0], hi[1], hi[2], hi[3]};
}
__device__ __forceinline__ bf16x8 pfrag(const f32x16& p, int s) {
    v4u w; w.x = cvtpk(p[8 * s + 0], p[8 * s + 1]); w.y = cvtpk(p[8 * s + 2], p[8 * s + 3]); w.z = cvtpk(p[8 * s + 4], p[8 * s + 5]); w.w = cvtpk(p[8 * s + 6], p[8 * s + 7]);
    return __builtin_bit_cast(bf16x8, w);
}

__device__ __forceinline__ void sbdma16(const void* gsrc, LAS unsigned char* dst) { unsigned keep; const unsigned d = (unsigned)__builtin_amdgcn_readfirstlane((int)(unsigned)(uintptr_t)dst);
    asm volatile("s_mov_b32 %0, m0\n\ts_mov_b32 m0, %2\n\ts_nop 0\n\tglobal_load_lds_dwordx4 %1, off\n\ts_mov_b32 m0, %0" : "=&s"(keep) : "v"(gsrc), "s"(d) : "memory"); }
constexpr int S2_K = 0, S2_V = 24576, S2_FLAG = 49152;
template <bool MASKED> __device__ __forceinline__ void sb_scores(f32x16 (&p)[2], float& carry, int kbase, int trow, int hi) {
    float lb[2][16];
#pragma unroll
    for (int blk = 0; blk < 2; ++blk)
#pragma unroll
        for (int r = 0; r < 16; ++r) {
            const float z = p[blk][r]; const bool valid = !MASKED || (kbase + 32 * blk + crow(r, hi)) < trow;
            const float sp = fmaxf(z, 0.f) + __builtin_amdgcn_logf(1.f + __builtin_amdgcn_exp2f(-fabsf(z)));
            lb[blk][r] = valid ? -sp : 0.f; p[blk][r] = valid ? (z - sp) : -1.0e30f;
        }
    float own[8], oth[8];
#pragma unroll
    for (int i = 0; i < 8; ++i) { const int blk = i >> 2, g = i & 3; own[i] = (lb[blk][4 * g] + lb[blk][4 * g + 1]) + (lb[blk][4 * g + 2] + lb[blk][4 * g + 3]); oth[i] = __shfl_xor(own[i], 32); }
    float suf[8]; float run = 0.f;
#pragma unroll
    for (int i = 7; i >= 0; --i) { suf[i] = run; run += own[i] + oth[i]; }
#pragma unroll
    for (int i = 0; i < 8; ++i) {
        const int blk = i >> 2, g = i & 3;
        const float off = carry + suf[i] + (hi == 0 ? oth[i] : 0.f);
        const float b3 = off, b2 = b3 + lb[blk][4 * g + 3], b1 = b2 + lb[blk][4 * g + 2], b0 = b1 + lb[blk][4 * g + 1];
        p[blk][4 * g + 0] = __builtin_amdgcn_exp2f(p[blk][4 * g + 0] + b0); p[blk][4 * g + 1] = __builtin_amdgcn_exp2f(p[blk][4 * g + 1] + b1);
        p[blk][4 * g + 2] = __builtin_amdgcn_exp2f(p[blk][4 * g + 2] + b2); p[blk][4 * g + 3] = __builtin_amdgcn_exp2f(p[blk][4 * g + 3] + b3);
    }
    carry += run;
}
constexpr float SB_CUT = -32.f;
__device__ __forceinline__ void sb_unit2(Frame& F, const bf16_t* proj, bf16_t* mix, int b, int h, int qb) {
    const int tid = opaque_i(F.tid), lane = tid & 63, r32 = lane & 31, hi = lane >> 5, wave = F.wave;
    LAS unsigned char* lds = F.lds + RING_OFF;
    LAS unsigned* flags = (LAS unsigned*)(lds + S2_FLAG);
    const bf16_t* base = proj + (size_t)b * SEQ * EVEN_IN;
    const int q0 = qb * 256, trow = q0 + 32 * wave + r32, mydiag = (q0 + 32 * wave) >> 6, jmax = (q0 >> 6) + 3;
    bf16x8 qr[4];
#pragma unroll
    for (int s = 0; s < 4; ++s) qr[s] = *(const GAS bf16x8*)(base + (size_t)trow * EVEN_IN + P0_SQ + h * 64 + s * 16 + hi * 8);
#pragma unroll
    for (int s = 0; s < 4; ++s) asm volatile("" : "+v"(qr[s]));
    if (tid < 8) flags[tid] = 0u;
    const int krow = 8 * wave + (lane >> 3), kch = (lane & 7) ^ ((krow >> 1) & 7);
    const bf16_t* kg0 = base + (size_t)krow * EVEN_IN + P0_SK + h * 64 + kch * 8;
    const bf16_t* vg0 = base + (size_t)((wave & 3) * 16 + (lane >> 2)) * EVEN_IN + P0_SV + h * 64 + (wave >> 2) * 32 + (lane & 3) * 8;
#define S2_DMA(t, bi) do { const size_t to_ = (size_t)(t) * 64 * EVEN_IN; sbdma16(kg0 + to_, lds + S2_K + (bi) * 8192 + wave * 1024); sbdma16(vg0 + to_, lds + S2_V + (bi) * 8192 + wave * 1024); } while (0)
    const int kswz = (r32 >> 1) & 7, krd = r32 * 128;
#define S2_KFRAG(kt, blk, s) (*(const LAS bf16x8*)((kt) + krd + (blk) * 4096 + ((((s) * 2 + hi) ^ kswz) << 4)))
    const int voff = vfrag_lane_off(lane);
    __syncthreads();
    int bj = jmax % 3;
    S2_DMA(jmax, bj); { const int b1_ = bj == 0 ? 2 : bj - 1; S2_DMA(jmax - 1, b1_); }
    f32x16 o0 = {}, o1 = {};
    float carry = 0.f;
    asm volatile("s_waitcnt vmcnt(2) lgkmcnt(0)" ::: "memory");
    __builtin_amdgcn_s_barrier();
    bool mydone = false, alldone = false;
#define S2_DMA_STEP(j_) do { if ((j_) >= 2) { const int b2_ = bj == 2 ? 0 : bj + 1; S2_DMA((j_) - 2, b2_); } } while (0)
#define S2_END_STEP(done_) do { if (lane == 0) flags[wave] = (done_) ? 1u : 0u; \
        if (j >= 2) asm volatile("s_waitcnt vmcnt(2) lgkmcnt(0)" ::: "memory"); else asm volatile("s_waitcnt vmcnt(0) lgkmcnt(0)" ::: "memory"); \
        __builtin_amdgcn_s_barrier(); asm volatile("" ::: "memory"); bj = bj == 0 ? 2 : bj - 1; unsigned f_ = 1u; _Pragma("unroll") for (int w_ = 0; w_ < 8; ++w_) f_ &= flags[w_]; alldone = f_ != 0u; } while (0)
#define S2_QK(kt_) do { p[0] = (f32x16){}; p[1] = (f32x16){}; _Pragma("unroll") for (int s_ = 0; s_ < 4; ++s_) { p[0] = MFMA32(S2_KFRAG((kt_), 0, s_), qr[s_], p[0]); p[1] = MFMA32(S2_KFRAG((kt_), 1, s_), qr[s_], p[1]); } } while (0)
#define S2_PV(vt_) do { _Pragma("unroll") for (int s_ = 0; s_ < 4; ++s_) { const bf16x8 pf_ = pfrag(p[s_ >> 1], s_ & 1); o0 = MFMA32(vfrag((vt_), 0, s_, voff), pf_, o0); o1 = MFMA32(vfrag((vt_), 1, s_, voff), pf_, o1); } } while (0)
    int j = jmax;
    while (j > mydiag) { S2_DMA_STEP(j); S2_END_STEP(false); --j; }
    {
        S2_DMA_STEP(j);
        const LAS unsigned char* kt = lds + S2_K + bj * 8192; const LAS unsigned char* vt = lds + S2_V + bj * 8192;
        f32x16 p[2]; S2_QK(kt);
        sb_scores<true>(p, carry, j * 64, trow, hi);
        S2_PV(vt);
        mydone = __all(carry < SB_CUT);
        S2_END_STEP(mydone); --j;
    }
    while (j >= 0 && !alldone && !mydone) {
        S2_DMA_STEP(j);
        const LAS unsigned char* kt = lds + S2_K + bj * 8192; const LAS unsigned char* vt = lds + S2_V + bj * 8192;
        f32x16 p[2]; S2_QK(kt);
        sb_scores<false>(p, carry, j * 64, trow, hi);
        S2_PV(vt);
        mydone = __all(carry < SB_CUT);
        S2_END_STEP(mydone); --j;
    }
    while (j >= 0 && !alldone) { S2_DMA_STEP(j); S2_END_STEP(true); --j; }
#undef S2_DMA
#undef S2_KFRAG
#undef S2_DMA_STEP
#undef S2_END_STEP
#undef S2_QK
#undef S2_PV
    asm volatile("s_waitcnt vmcnt(0) lgkmcnt(0)" ::: "memory");
    bf16_t* op = mix + ((size_t)b * SEQ + trow) * D + h * 64;
#pragma unroll
    for (int g = 0; g < 4; ++g) {
        v2u w0; w0.x = cvtpk(o0[4 * g], o0[4 * g + 1]); w0.y = cvtpk(o0[4 * g + 2], o0[4 * g + 3]);
        v2u w1; w1.x = cvtpk(o1[4 * g], o1[4 * g + 1]); w1.y = cvtpk(o1[4 * g + 2], o1[4 * g + 3]);
        *(GAS v2u*)(op + 8 * g + 4 * hi) = w0; *(GAS v2u*)(op + 32 + 8 * g + 4 * hi) = w1;
    }
    __syncthreads();
}

__device__ __forceinline__ float ret_log2gamma(int h) { return __builtin_amdgcn_logf(1.f - __builtin_amdgcn_exp2f(-5.f - (float)h)); }
__device__ __forceinline__ void ret_kv_phase(Frame& F, const bf16_t* proj, bf16_t* state, bf16_t* tot) {
    const int tid = opaque_i(F.tid), lane = tid & 63, r32 = lane & 31, hi = lane >> 5, wave = F.wave;
    LAS unsigned char* lds = F.lds + RING_OFF;
    LAS unsigned char* oimg = lds + 32768;
    const int eb = wave >> 1, voffn = vfragn_lane_off(lane);
    v4u kreg[2], vreg[2];
    for (int gu = F.vcu; gu < 256; gu += F.G) {
        const int bh = gu >> 4, grp = gu & 15, h = bh & 3;
        const float lg2 = ret_log2gamma(h), dec64 = __builtin_amdgcn_exp2f(lg2 * 64.f);
        { const bf16_t* base = proj + ((size_t)(bh >> 2) * SEQ + (grp * 8) * 64) * EVEN_IN;
          vtile_load<4>(kreg, base + P0_RK + h * 128, EVEN_IN, tid); vtile_load<4>(vreg, base + P0_RV + h * 128, EVEN_IN, tid); }
        f32x16 acc[2]; acc[0] = (f32x16){}; acc[1] = (f32x16){};
        for (int j = 0; j <= 8; ++j) {
            const int n = grp * 8 + j;
            if (j < 8) {
#pragma unroll
                for (int i = 0; i < 2; ++i) { const int item = tid + 512 * i, row = item / 16; const float dec = __builtin_amdgcn_exp2f(lg2 * (float)(63 - row));
                    v4u k = kreg[i];
                    k.x = cvtpk_c(__uint_as_float(k.x << 16) * dec, __uint_as_float(k.x & 0xffff0000u) * dec); k.y = cvtpk_c(__uint_as_float(k.y << 16) * dec, __uint_as_float(k.y & 0xffff0000u) * dec);
                    k.z = cvtpk_c(__uint_as_float(k.z << 16) * dec, __uint_as_float(k.z & 0xffff0000u) * dec); k.w = cvtpk_c(__uint_as_float(k.w << 16) * dec, __uint_as_float(k.w & 0xffff0000u) * dec);
                    kreg[i] = k; }
                vtile_store<4>(kreg, lds, tid); vtile_store<4>(vreg, lds + 16384, tid);
                if (j < 7) { const bf16_t* base2 = proj + ((size_t)(bh >> 2) * SEQ + (n + 1) * 64) * EVEN_IN;
                    vtile_load<4>(kreg, base2 + P0_RK + h * 128, EVEN_IN, tid); vtile_load<4>(vreg, base2 + P0_RV + h * 128, EVEN_IN, tid); }
            }
#pragma unroll
            for (int i = 0; i < 2; ++i)
#pragma unroll
                for (int r = 0; r < 16; ++r) *(LAS bf16_t*)(oimg + (eb * 32 + crow(r, hi)) * 272 + ((2 * (wave & 1) + i) * 32 + r32) * 2) = (bf16_t)f2bf(acc[i][r]);
            __syncthreads();
            bf16_t* st = (j < 8) ? state + ((size_t)bh * 128 + n) * 16384 : tot + ((size_t)bh * 16 + grp) * 16384;
#pragma unroll
            for (int i = 0; i < 4; ++i) { const int item = tid + 512 * i, e = item >> 4, c = item & 15; *(GAS v4u*)(st + (size_t)e * 128 + c * 8) = *(const LAS v4u*)(oimg + e * 272 + c * 16); }
            if (j < 8) {
#pragma unroll
                for (int i = 0; i < 2; ++i)
#pragma unroll
                    for (int r = 0; r < 16; ++r) acc[i][r] *= dec64;
#pragma unroll
                for (int s = 0; s < 4; ++s) { const bf16x8 af = vfragn(lds + 16384, eb, s, voffn);
#pragma unroll
                    for (int i = 0; i < 2; ++i) acc[i] = MFMA32(af, vfragn(lds, 2 * (wave & 1) + i, s, voffn), acc[i]); }
            }
            __syncthreads();
        }
    }
}
__device__ __forceinline__ void ret_scan(Frame& F, const bf16_t* tot, bf16_t* gst) {
    const int gt = F.vcu * NWAVES * 64 + opaque_i(F.tid);
    for (int p = gt; p < 16 * 8192; p += F.G * NWAVES * 64) {
        const int bh = p >> 13, pr = p & 8191; const float dec = __builtin_amdgcn_exp2f(ret_log2gamma(bh & 3) * 512.f);
        const GAS unsigned* ptr = (const GAS unsigned*)(tot + (size_t)bh * 16 * 16384) + pr; GAS unsigned* optr = (GAS unsigned*)(gst + (size_t)bh * 16 * 16384) + pr;
        float s0 = 0.f, s1 = 0.f;
#pragma unroll
        for (int g = 0; g < 16; ++g) { const unsigned kv = ptr[(size_t)g * 8192]; optr[(size_t)g * 8192] = cvtpk_c(s0, s1);
            s0 = dec * s0 + __uint_as_float(kv << 16); s1 = dec * s1 + __uint_as_float(kv & 0xffff0000u); }
    }
}
constexpr int RO_LDS_K = 0, RO_LDS_V = 16 * KCH, RO_LDS_ST = RO_LDS_V + 16384;
__device__ __forceinline__ void ret_out_phase(Frame& F, const bf16_t* proj, const bf16_t* state, const bf16_t* gst, const float* gn, bf16_t* mix) {
    const int tid = opaque_i(F.tid), lane = tid & 63, r32 = lane & 31, hi = lane >> 5, wave = F.wave;
    LAS unsigned char* lds = F.lds + RING_OFF;
    v4u kreg[2], vreg[2];
    int u = F.vcu;
    if (u < 2048) { const int bh0 = u >> 7, n0 = u & 127; const bf16_t* base0 = proj + ((size_t)(bh0 >> 2) * SEQ + n0 * 64) * EVEN_IN;
        ktile_load<16>(kreg, base0 + P0_RK + (bh0 & 3) * 128, EVEN_IN, tid); vtile_load<4>(vreg, base0 + P0_RV + (bh0 & 3) * 128, EVEN_IN, tid); }
    for (; u < 2048; u += F.G) {
    const int bh = u >> 7, n = u & 127, b = bh >> 2, h = bh & 3;
    const bf16_t* base = proj + ((size_t)b * SEQ + n * 64) * EVEN_IN;
    const float lg2 = ret_log2gamma(h);
    const int eb = wave >> 1, cb = wave & 1, c = cb * 32 + r32;
    bf16x8 qf[8];
#pragma unroll
    for (int s = 0; s < 8; ++s) qf[s] = *(const GAS bf16x8*)(base + (size_t)c * EVEN_IN + P0_RQ + h * 128 + s * 16 + hi * 8);
    ktile_store<16>(kreg, lds + RO_LDS_K, tid); vtile_store<4>(vreg, lds + RO_LDS_V, tid);
    const bf16_t* st = state + ((size_t)bh * 128 + n) * 16384 + (size_t)(eb * 32 + r32) * 128;
    const bf16_t* sg = gst + ((size_t)bh * 16 + (n >> 3)) * 16384 + (size_t)(eb * 32 + r32) * 128;
    f32x16 oj = {}, og = {};
#pragma unroll
    for (int s = 0; s < 8; ++s) og = MFMA32(*(const GAS bf16x8*)(sg + s * 16 + hi * 8), qf[s], og);
    __builtin_amdgcn_sched_barrier(0);
#pragma unroll
    for (int s = 0; s < 8; ++s) oj = MFMA32(*(const GAS bf16x8*)(st + s * 16 + hi * 8), qf[s], oj);
    { const float gd = __builtin_amdgcn_exp2f(lg2 * (float)(64 * (n & 7)));
#pragma unroll
      for (int r = 0; r < 16; ++r) oj[r] += gd * og[r]; }
    __builtin_amdgcn_sched_barrier(0);
    { const int un = u + F.G; if (un < 2048) { const int bh2 = un >> 7, n2 = un & 127; const bf16_t* base2 = proj + ((size_t)(bh2 >> 2) * SEQ + n2 * 64) * EVEN_IN;
        ktile_load<16>(kreg, base2 + P0_RK + (bh2 & 3) * 128, EVEN_IN, tid); vtile_load<4>(vreg, base2 + P0_RV + (bh2 & 3) * 128, EVEN_IN, tid); } }
    __syncthreads();
    f32x16 p[2]; p[0] = (f32x16){}; p[1] = (f32x16){};
#pragma unroll
    for (int s = 0; s < 8; ++s) { p[0] = MFMA32(kfrag(lds + RO_LDS_K, 0, s, r32, hi), qf[s], p[0]); p[1] = MFMA32(kfrag(lds + RO_LDS_K, 1, s, r32, hi), qf[s], p[1]); }
#pragma unroll
    for (int blk = 0; blk < 2; ++blk)
#pragma unroll
        for (int r = 0; r < 16; ++r) p[blk][r] *= __builtin_amdgcn_exp2f(lg2 * fabsf((float)(c - (32 * blk + crow(r, hi)))));
    const int voff = vfrag_lane_off(lane);
    f32x16 o = {};
#pragma unroll
    for (int s = 0; s < 4; ++s) o = MFMA32(vfrag(lds + RO_LDS_V, eb, s, voff), pfrag(p[s >> 1], s & 1), o);
    const float qd = __builtin_amdgcn_exp2f(lg2 * (float)(c + 1));
    float s1 = 0.f, s2 = 0.f;
#pragma unroll
    for (int r = 0; r < 16; ++r) { o[r] += qd * oj[r]; s1 += o[r]; s2 += o[r] * o[r]; }
    s1 += __shfl_xor(s1, 32); s2 += __shfl_xor(s2, 32);
    typedef float f32x2v __attribute__((ext_vector_type(2)));
    LAS f32x2v* stt = (LAS f32x2v*)(lds + RO_LDS_ST);
    if (hi == 0) stt[eb * 64 + c] = (f32x2v){s1, s2};
    __syncthreads();
    float t1 = 0.f, t2 = 0.f;
#pragma unroll
    for (int i = 0; i < 4; ++i) { const f32x2v v = stt[i * 64 + c]; t1 += v.x; t2 += v.y; }
    const float mu = t1 * (1.f / 128.f), rstd = rsqrtf(fmaxf(t2 * (1.f / 128.f) - mu * mu, 0.f) + LN_EPS);
    const bf16_t* gp = base + (size_t)c * EVEN_IN + P0_RG + h * 128 + eb * 32;
    bf16_t* op = mix + ((size_t)b * SEQ + n * 64 + c) * D + 512 + h * 128 + eb * 32;
    const float* gnp = gn + h * 128 + eb * 32;
#pragma unroll
    for (int g = 0; g < 4; ++g) {
        const int e0 = 8 * g + 4 * hi; const v2u gg = *(const GAS v2u*)(gp + e0); const f32x4 gain = *(const f32x4*)(gnp + e0);
        const float g0 = __uint_as_float(gg.x << 16), g1 = __uint_as_float(gg.x & 0xffff0000u), g2 = __uint_as_float(gg.y << 16), g3 = __uint_as_float(gg.y & 0xffff0000u);
        v2u w; w.x = cvtpk((o[4 * g] - mu) * rstd * gain.x * silu_f(g0), (o[4 * g + 1] - mu) * rstd * gain.y * silu_f(g1));
        w.y = cvtpk((o[4 * g + 2] - mu) * rstd * gain.z * silu_f(g2), (o[4 * g + 3] - mu) * rstd * gain.w * silu_f(g3));
        *(GAS v2u*)(op + e0) = w;
    }
    __syncthreads();
    }
}

__device__ __forceinline__ void phase_mixa0(Frame& F, const Args& a) {
    const bf16_t* proj = (const bf16_t*)(a.ws + WS_BIG); bf16_t* mix = (bf16_t*)(a.ws + WS_MIX); bf16_t* state = (bf16_t*)(a.ws + WS_U);
    ret_kv_phase(F, proj, state, (bf16_t*)a.out);
#if defined(PROBE_MIXA) && PROBE_MIXA == 2
    for (int u = F.vcu; u < 1024; u += F.G) sb_unit2(F, proj, mix, u >> 8, (u >> 5) & 7, u & 31);
#endif
    for (int u = F.vcu; u < 1024; u += F.G) sb_unit2(F, proj, mix, u >> 8, (u >> 5) & 7, u & 31);
}
__device__ __forceinline__ void phase_scan0(Frame& F, const Args& a) { ret_scan(F, (const bf16_t*)a.out, (bf16_t*)a.out + 256 * 16384); }
__device__ __forceinline__ void phase_mixb0(Frame& F, const Args& a) {
    const bf16_t* proj = (const bf16_t*)(a.ws + WS_BIG); bf16_t* mix = (bf16_t*)(a.ws + WS_MIX); const bf16_t* state = (const bf16_t*)(a.ws + WS_U);
    ret_out_phase(F, proj, state, (const bf16_t*)a.out + 256 * 16384, a.in[10], mix);
}

constexpr float DF_THR = 64.f;
__device__ __forceinline__ void dma16(const void* gsrc, LAS unsigned char* dst) { unsigned keep; const unsigned d = (unsigned)__builtin_amdgcn_readfirstlane((int)(unsigned)(uintptr_t)dst);
    asm volatile("s_mov_b32 %0, m0\n\ts_mov_b32 m0, %2\n\ts_nop 0\n\tglobal_load_lds_dwordx4 %1, off\n\ts_mov_b32 m0, %0" : "=&s"(keep) : "v"(gsrc), "s"(d) : "memory"); }
constexpr int D3_K0 = 0, D3_K1 = 32768, D3_V = 65536;
constexpr int D3_KN = TT_LDS_OFF, D3_FLAG = TT_LDS_OFF + 1024, D3_Q = TT_LDS_OFF + 1088;
#ifndef PROBE_CUTX
#define PROBE_CUTX 0.f
#endif
template <int PVAR> __device__ __forceinline__ void diff_unit3(Frame& F, const bf16_t* proj, bf16_t* mix, const float* subg, const float* kn2, float lam, int b, int h, int qb) {
    const int tid = opaque_i(F.tid), lane = tid & 63, r32 = lane & 31, hi = lane >> 5, wave = F.wave, m = wave >> 2, wq = wave & 3;
    LAS unsigned char* lds = F.lds + RING_OFF;
    LAS float* KN = (LAS float*)(F.lds + D3_KN); LAS unsigned* flags = (LAS unsigned*)(F.lds + D3_FLAG);
    const bf16_t* base = proj + (size_t)b * SEQ * ODD_IN;
    const int q0 = qb * 128, trow = q0 + 32 * wq + r32, pmax = qb;
    const float slope2 = __builtin_amdgcn_exp2f(-(float)(h + 1)) * LOG2E;
    bf16x8 qr[4];
#pragma unroll
    for (int s = 0; s < 4; ++s) qr[s] = *(const GAS bf16x8*)(base + (size_t)trow * ODD_IN + P1_Q + h * 128 + m * 64 + s * 16 + hi * 8);
    float qn;
    { float t = 0.f;
#pragma unroll
      for (int s = 0; s < 4; ++s) { const v4u v = __builtin_bit_cast(v4u, qr[s]);
          t += __uint_as_float(v.x << 16) * __uint_as_float(v.x << 16) + __uint_as_float(v.x & 0xffff0000u) * __uint_as_float(v.x & 0xffff0000u);
          t += __uint_as_float(v.y << 16) * __uint_as_float(v.y << 16) + __uint_as_float(v.y & 0xffff0000u) * __uint_as_float(v.y & 0xffff0000u);
          t += __uint_as_float(v.z << 16) * __uint_as_float(v.z << 16) + __uint_as_float(v.z & 0xffff0000u) * __uint_as_float(v.z & 0xffff0000u);
          t += __uint_as_float(v.w << 16) * __uint_as_float(v.w << 16) + __uint_as_float(v.w & 0xffff0000u) * __uint_as_float(v.w & 0xffff0000u); }
      t += __shfl_xor(t, 32); qn = sqrtf(t) * 1.0001f; }
    if (wq == 0) {
        const f32x4 kv = *(const f32x4*)(kn2 + (((size_t)b * 16 + h * 2 + m) * 128 + 2 * lane) * 2);
        float v0 = kv.x + kv.y, v1 = kv.z + kv.w; v1 = fmaxf(v0, v1);
        float run = v1;
#pragma unroll
        for (int o = 1; o < 64; o <<= 1) { const float t = __shfl_up(run, o); if (lane >= o) run = fmaxf(run, t); }
        const float prev = __shfl_up(run, 1);
        KN[m * 128 + 2 * lane] = sqrtf(lane ? fmaxf(prev, v0) : v0); KN[m * 128 + 2 * lane + 1] = sqrtf(run);
    }
    if (tid < 8) flags[tid] = 0u;
    const int krow = 8 * wave + (lane >> 3), kch = (lane & 7) ^ ((krow >> 1) & 7);
    const bf16_t* kg0 = base + (size_t)krow * ODD_IN + P1_K + h * 128 + kch * 8;
    const int vs0 = 2 * wave, vs1 = 2 * wave + 1;
    const bf16_t* vg0 = base + (size_t)((vs0 & 3) * 16 + (lane >> 2)) * ODD_IN + P1_V + h * 128 + (vs0 >> 2) * 32 + (lane & 3) * 8;
    const bf16_t* vg1 = base + (size_t)((vs1 & 3) * 16 + (lane >> 2)) * ODD_IN + P1_V + h * 128 + (vs1 >> 2) * 32 + (lane & 3) * 8;
#define D3_DMA_T(t) do { if (PVAR == 4) break; const size_t to_ = (size_t)(t) * 64 * ODD_IN; const int sl_ = (t) & 3; LAS unsigned char* kb_ = lds + sl_ * 8192 + wave * 1024; LAS unsigned char* vb_ = lds + D3_V + sl_ * 16384; \
        dma16(kg0 + to_, kb_ + D3_K0); dma16(kg0 + to_ + 64, kb_ + D3_K1); dma16(vg0 + to_, vb_ + vs0 * 1024); dma16(vg1 + to_, vb_ + vs1 * 1024); } while (0)
#define D3_DMA_PAIR(p_) do { D3_DMA_T(2 * (p_) + 1); D3_DMA_T(2 * (p_)); } while (0)
    const int kswz = (r32 >> 1) & 7, krd = r32 * 128;
#define D3_KFRAG(kt, blk, s) (*(const LAS bf16x8*)((kt) + krd + (blk) * 4096 + ((((s) * 2 + hi) ^ kswz) << 4)))
    const int voff = vfrag_lane_off(lane);
    __syncthreads();
    D3_DMA_PAIR(pmax); if (pmax >= 1) D3_DMA_PAIR(pmax - 1);
    f32x16 o[4]; o[0] = (f32x16){}; o[1] = (f32x16){}; o[2] = (f32x16){}; o[3] = (f32x16){};
    float mref = -1.0e30f, l = 0.f, skl = 0.f;
    const float tgeo = -__builtin_amdgcn_logf(1.f - __builtin_amdgcn_exp2f(-64.f * slope2));
    if (pmax >= 1) asm volatile("s_waitcnt vmcnt(8) lgkmcnt(0)" ::: "memory"); else asm volatile("s_waitcnt vmcnt(0) lgkmcnt(0)" ::: "memory");
    __builtin_amdgcn_s_barrier();
    bool mydone = false, alldone = false;
    const float c4hi = slope2 * (float)(4 * hi), c32 = slope2 * 32.f;
    bf16x8 vf[2][4];
#define D3_VPRE(vt_) do { _Pragma("unroll") for (int db_ = 0; db_ < 4; ++db_) vf[0][db_] = vfrag((vt_), db_, 0, voff); __builtin_amdgcn_sched_barrier(0); } while (0)
#define D3_PV(vt_, SUB) do { float ls_ = 0.f; _Pragma("unroll") for (int s_ = 0; s_ < 4; ++s_) { \
            if (s_ < 3) { _Pragma("unroll") for (int db_ = 0; db_ < 4; ++db_) vf[(s_ + 1) & 1][db_] = vfrag((vt_), db_, s_ + 1, voff); } \
            f32x16& sc_ = (s_ >> 1) ? sc1 : sc0; \
            _Pragma("unroll") for (int r_ = 8 * (s_ & 1); r_ < 8 * (s_ & 1) + 8; ++r_) { sc_[r_] = __builtin_amdgcn_exp2f(sc_[r_] - (SUB)); ls_ += sc_[r_]; } \
            const bf16x8 pf_ = pfrag(sc_, s_ & 1); \
            _Pragma("unroll") for (int db_ = 0; db_ < 4; ++db_) o[db_] = MFMA32(vf[s_ & 1][db_], pf_, o[db_]); \
            __builtin_amdgcn_sched_barrier(0); } l += ls_; } while (0)
#define D3_DIAG(jt) do { const LAS unsigned char* kt = lds + (m ? D3_K1 : D3_K0) + ((jt) & 3) * 8192; const LAS unsigned char* vt = lds + D3_V + ((jt) & 3) * 16384; \
        f32x16 sc0 = {}, sc1 = {}; bf16x8 kf[4][2]; \
        _Pragma("unroll") for (int s = 0; s < 4; ++s) { kf[s][0] = D3_KFRAG(kt, 0, s); kf[s][1] = D3_KFRAG(kt, 1, s); } \
        __builtin_amdgcn_sched_barrier(0); \
        _Pragma("unroll") for (int s = 0; s < 4; ++s) { sc0 = MFMA32(kf[s][0], qr[s], sc0); sc1 = MFMA32(kf[s][1], qr[s], sc1); } \
        D3_VPRE(vt); \
        const float dq = (float)(trow - (jt) * 64); float mx = -1.0e30f; \
        _Pragma("unroll") for (int r = 0; r < 16; ++r) { sc0[r] -= slope2 * fabsf(dq - (float)crow(r, hi)); sc1[r] -= slope2 * fabsf(dq - (float)(32 + crow(r, hi))); mx = fmaxf(mx, fmaxf(sc0[r], sc1[r])); } \
        mx = fmaxf(mx, __shfl_xor(mx, 32)); mref = mx; l = 0.f; \
        D3_PV(vt, mx); } while (0)
#define D3_NORMAL(jt, knv) do { const float bnd = qn * (knv) - slope2 * (float)(trow - (64 * (jt) + 63)) - mref; \
        if (__all(bnd < -(PROBE_CUTX + 32.f + tgeo))) { mydone = true; break; } \
        if (PVAR == 9) break;          \
        const LAS unsigned char* kt = lds + (m ? D3_K1 : D3_K0) + ((jt) & 3) * 8192; const LAS unsigned char* vt = lds + D3_V + ((jt) & 3) * 16384; \
        f32x16 sc0, sc1; bf16x8 kf[4][2]; \
        _Pragma("unroll") for (int s = 0; s < 4; ++s) { kf[s][0] = D3_KFRAG(kt, 0, s); kf[s][1] = D3_KFRAG(kt, 1, s); } \
        __builtin_amdgcn_sched_barrier(0); \
        { const float loff = slope2 * (float)(64 * (jt) - trow) - mref + c4hi; \
          _Pragma("unroll") for (int r = 0; r < 16; ++r) { sc0[r] = fmaf(slope2, (float)((r & 3) + 8 * (r >> 2)), loff); sc1[r] = sc0[r] + c32; } } \
        _Pragma("unroll") for (int s = 0; s < 4; ++s) { sc0 = MFMA32(kf[s][0], qr[s], sc0); sc1 = MFMA32(kf[s][1], qr[s], sc1); } \
        if (__all(bnd < -20.f)) {         \
            float mq = -1.0e30f; _Pragma("unroll") for (int r = 0; r < 16; ++r) mq = fmaxf(mq, fmaxf(sc0[r], sc1[r])); \
            const float add = 32.f * __builtin_amdgcn_exp2f(mq); if (__all(skl + add <= 0x1p-27f)) { skl += add; break; } } \
        D3_VPRE(vt); \
        if (__any(bnd > DF_THR)) { float mx = -1.0e30f; \
            _Pragma("unroll") for (int r = 0; r < 16; ++r) mx = fmaxf(mx, fmaxf(sc0[r], sc1[r])); \
            mx = fmaxf(mx, __shfl_xor(mx, 32)); \
            if (__any(mx > DF_THR)) { const float dl = fmaxf(mx, 0.f), f = __builtin_amdgcn_exp2f(-dl); mref += dl; l *= f; skl *= f; \
                _Pragma("unroll") for (int db = 0; db < 4; ++db) _Pragma("unroll") for (int r = 0; r < 16; ++r) asm volatile("v_mul_f32 %0, %0, %1" : "+v"(o[db][r]) : "v"(f)); \
                _Pragma("unroll") for (int r = 0; r < 16; ++r) { sc0[r] -= dl; sc1[r] -= dl; } } } \
        D3_PV(vt, 0.f); } while (0)
#define D3_END_STEP(done_) do { if (lane == 0) flags[wave] = (done_) ? 1u : 0u; if (p >= 1) { knA = KN[m * 128 + 2 * p - 1]; knB = KN[m * 128 + 2 * p - 2]; } \
        asm volatile("s_waitcnt vmcnt(0) lgkmcnt(0)" ::: "memory");        \
        __builtin_amdgcn_s_barrier(); asm volatile("" ::: "memory"); unsigned f_ = 1u; _Pragma("unroll") for (int w_ = 0; w_ < 8; ++w_) f_ &= flags[w_]; alldone = f_ != 0u; } while (0)
    if (m) __builtin_amdgcn_s_setprio(1);
    int p = pmax; float knA = 0.f, knB = 0.f;
    {
        if (wq >= 2) { D3_DIAG(2 * p + 1); D3_NORMAL(2 * p, KN[m * 128 + 2 * p]); } else { D3_DIAG(2 * p); }
        D3_END_STEP(mydone); --p;
    }
    while (p >= 0 && !alldone) {
        if (p >= 1) D3_DMA_PAIR(p - 1);
        const float kn1 = knA, kn0 = knB;
        if (!mydone) { D3_NORMAL(2 * p + 1, kn1); }
        if (!mydone) { D3_NORMAL(2 * p, kn0); }
        D3_END_STEP(mydone); --p;
    }
    __builtin_amdgcn_s_setprio(0);
#undef D3_DMA_T
#undef D3_DMA_PAIR
#undef D3_KFRAG
#undef D3_VPRE
#undef D3_PV
#undef D3_DIAG
#undef D3_NORMAL
#undef D3_END_STEP
    asm volatile("s_waitcnt vmcnt(0) lgkmcnt(0)" ::: "memory");
    __syncthreads();
    l += __shfl_xor(l, 32);
    const float inv = 1.f / l;
    LAS float* X = (LAS float*)lds;
    if (m == 1) {
#pragma unroll
        for (int db = 0; db < 4; ++db)
#pragma unroll
            for (int r = 0; r < 16; ++r) X[((wq * 4 + db) * 16 + r) * 64 + lane] = o[db][r] * inv;
    }
    __syncthreads();
    if (m == 0) {
        float ss = 0.f;
#pragma unroll
        for (int db = 0; db < 4; ++db)
#pragma unroll
            for (int r = 0; r < 16; ++r) { const float av = o[db][r] * inv - lam * X[((wq * 4 + db) * 16 + r) * 64 + lane]; o[db][r] = av; ss += av * av; }
        ss += __shfl_xor(ss, 32);
        const float rs = rsqrtf(ss * (1.f / 128.f) + LN_EPS) * (1.f - LAMBDA_INIT1);
        bf16_t* op = mix + ((size_t)b * SEQ + trow) * D + h * 128;
#pragma unroll
        for (int db = 0; db < 4; ++db)
#pragma unroll
            for (int g = 0; g < 4; ++g) { const int e0 = db * 32 + 8 * g + 4 * hi; const f32x4 sg = *(const f32x4*)(subg + e0);
                v2u w; w.x = cvtpk(o[db][4 * g] * rs * sg.x, o[db][4 * g + 1] * rs * sg.y); w.y = cvtpk(o[db][4 * g + 2] * rs * sg.z, o[db][4 * g + 3] * rs * sg.w);
                *(GAS v2u*)(op + e0) = w; }
    }
    __syncthreads();
}
template <int PVAR> __device__ __forceinline__ void phase_diff(Frame& F, const Args& a) {
    const bf16_t* proj = (const bf16_t*)(a.ws + WS_BIG); bf16_t* mix = (bf16_t*)(a.ws + WS_MIX); const float* kn2 = (const float*)((const unsigned*)(a.ws + WS_CTL) + CW_KNA);
    float s1 = 0.f, s2 = 0.f;
    for (int i = 0; i < 64; ++i) { s1 += a.in[13][i] * a.in[14][i]; s2 += a.in[15][i] * a.in[16][i]; }
    const float lam = __expf(s1) - __expf(s2) + LAMBDA_INIT1;
    LAS int* qw = (LAS int*)(F.lds + D3_Q);
    gu32* heads = F.ctl + CW_QDIFF + (PVAR ? 1024 : 0);
    int q = (F.G % 8 == 0) ? (F.vcu / (F.G / 8)) : (int)(blockIdx.x & 7), tries = 0;
    for (;;) {
        if (F.tid == 0) qw[0] = (int)__hip_atomic_fetch_add(heads + 64 * q, 1u, RLX_AGENT);
        __syncthreads();
        const int k = qw[0];
        __syncthreads();
        if (k >= 256) { if (++tries >= 8) break; q = (q + 1) & 7; continue; }
        const int si = k >> 6, qb = 63 - (k & 63), b = q & 3;
        const int h = (q < 4) ? (si == 0 ? 7 : (si == 1 ? 4 : (si == 2 ? 3 : 0))) : (si == 0 ? 6 : (si == 1 ? 5 : (si == 2 ? 2 : 1)));
        diff_unit3<PVAR>(F, proj, mix, a.in[17], kn2, lam, b, h, qb);
    }
}
#ifndef PROBE_DIFFV
#define PROBE_DIFFV 0
#endif
#define PHASE_MIXA if constexpr (l == 0) phase_mixa0(F, a); else { if (PROBE_DIFFV > 0) phase_diff<PROBE_DIFFV>(F, a); phase_diff<0>(F, a); }
#define PHASE_SCAN phase_scan0(F, a);
#define PHASE_MIXB phase_mixb0(F, a);
#define PHASE_LNR phase_lnr(F, a, l, DRY);
#define PHASE_COMB phase_comb(F, a, l);
constexpr int NSLOTS = 22;
#ifndef PROBE_DUP
#define PROBE_DUP (-1)
#endif
#define REP(k) for (int rep_ = 0; rep_ < (((k) == PROBE_DUP) ? 2 : 1); ++rep_)
#define DRYK(k) (((k) == PROBE_DUP) && rep_ == 0)
#ifndef PROBE_OUTX
#define PROBE_OUTX 0
#endif
struct KArgs { const float* in[25]; float* out; unsigned char* ws; int ph_lo, ph_hi, li, pad; };

#define IN(k) (lo <= (k) && (k) < hi)
#if defined(PROBE_BAR2)
#define GRID_BAR(k) do { if ((k) + 1 < hi) { xcd_barrier(bar); xcd_barrier(bar); } } while (0)
#else
#define GRID_BAR(k) do { if ((k) + 1 < hi) xcd_barrier(bar); } while (0)
#endif
template <int l> __device__ __forceinline__ void layer_body(Frame& F, const Args& a, const int lo, const int hi, const XcdBarrier& bar) {
    unsigned char* ws = a.ws;
    bf16_t* U = (bf16_t*)(ws + WS_U); bf16_t* MIX = (bf16_t*)(ws + WS_MIX); bf16_t* PROJ = (bf16_t*)(ws + WS_BIG); bf16_t* XS = (bf16_t*)(ws + WS_XS); bf16_t* Hb = (bf16_t*)(ws + WS_H);
    const float* mod = (const float*)(ws + WS_MOD);
        const int base = 2 + 10 * l;
    if (IN(base + 0)) { REP(base + 0) {
        const int N = l ? ODD_IN : EVEN_IN;
        pg8::Gemm g{U, (const bf16_t*)(ws + (l ? WS_WIN1 : WS_WIN0)), T, N, D}; pg8::StaticOrder S; S.init(T, N, F.G, (int)blockIdx.x);
        if constexpr (l == 0) { pg8::EpiStoreBf16 E{PROJ, N, 0xffff}; pg8::gemm_phase<pg8::EpiStoreBf16, pg8::StaticOrder, true, true>(F.lds + RING_OFF, g, S, E); }
        else { pg8::EpiProj1 E{PROJ, N, (unsigned*)(ws + WS_CTL) + CW_KNA}; pg8::gemm_phase<pg8::EpiProj1, pg8::StaticOrder, true, true>(F.lds + RING_OFF, g, S, E); } }
        GRID_BAR(base + 0);
    }
    if (IN(base + 1)) { REP(base + 1) { PHASE_MIXA } bg_pump(F, a, l == 0 ? 2 : 3); GRID_BAR(base + 1); }
    if (l == 0) {
        if (IN(base + 2)) { PHASE_SCAN GRID_BAR(base + 2); }
        if (IN(base + 3)) { REP(base + 3) { PHASE_MIXB } GRID_BAR(base + 3); }
    }
    if (IN(base + 4)) { REP(base + 4) { const bool DRYO = DRYK(base + 4);
        pg8::Gemm g{MIX, (const bf16_t*)(ws + (l ? WS_WOUT1 : WS_WOUT0)), T, D, D}; pg8::StaticOrder S; S.init(T, D, F.G, (int)blockIdx.x);
        pg8::EpiOut<true> E{(bf16_t*)(ws + WS_Y), (l || (DRYO && PROBE_OUTX == 1)) ? (const void*)a.out : (const void*)((const bf16_t*)a.out + (size_t)T * D), mod + (size_t)l * 4 * 6 * D + 2 * D, (float*)(ws + WS_STATS)};
        pg8::gemm_phase<pg8::EpiOut<true>, pg8::StaticOrder, true, true>(F.lds + RING_OFF, g, S, E); }
        GRID_BAR(base + 4);
    }
    if (IN(base + 5)) { { const bool DRY = false; PHASE_LNR } if (l == 1) bg_pump(F, a, -1); GRID_BAR(base + 5); }
    if (IN(base + 7)) { REP(base + 7) {
        pg8::Gemm g{(const bf16_t*)ws, (const bf16_t*)(ws + WS_W13) + (size_t)l * NEXP * 1024 * 1024, PMAX, 1024, D}; LAS int* ttl = (LAS int*)(F.lds + TT_LDS_OFF); moe_tables(F, a, l, true, true);
        pg8::MoeOrder S; S.init(ttl, F.G, F.vcu);
        pg8::EpiMoe1 E{Hb};
        pg8::gemm_phase<pg8::EpiMoe1, pg8::MoeOrder, true, true, true>(F.lds + RING_OFF, g, S, E, (const LAS unsigned*)(F.lds + GOFF_LDS_OFF)); }
        if (l == 0) bg_pump(F, a, 0);
        GRID_BAR(base + 7);
    }
    if (IN(base + 8)) { REP(base + 8) {
        pg8::Gemm g{Hb, (const bf16_t*)(ws + WS_W2) + (size_t)l * NEXP * 1024 * 512, PMAX, 1024, FF}; LAS int* ttl = (LAS int*)(F.lds + TT_LDS_OFF); moe_tables(F, a, l, true, false);
        pg8::MoeOrder S; S.init(ttl, F.G, F.vcu);
        pg8::EpiStoreBf16 E{XS, D, 3};
        pg8::gemm_phase<pg8::EpiStoreBf16, pg8::MoeOrder, true, true>(F.lds + RING_OFF, g, S, E); }
        if (l == 0) bg_pump(F, a, 1);
        GRID_BAR(base + 8);
    }
    if (IN(base + 9)) { REP(base + 9) { PHASE_COMB } GRID_BAR(base + 9); }
}
#undef IN
#undef GRID_BAR

__global__ void __launch_bounds__(NWAVES * 64, 2) mega(KArgs args) {
    extern __shared__ __attribute__((aligned(16))) unsigned char lds[];
    Frame F;
    F.lds = (LAS unsigned char*)lds;
    F.MISC = (volatile LAS unsigned*)(F.lds + MISC_OFF);
    F.tid = threadIdx.x; F.lane = F.tid & 63; F.wave = __builtin_amdgcn_readfirstlane(F.tid >> 6);
    F.G = gridDim.x; { const int bx = blockIdx.x; F.vcu = (F.G % 8 == 0) ? (bx % 8) * (F.G / 8) + bx / 8 : bx; }
    unsigned char* ws = args.ws;
    F.ctl = (gu32*)(ws + WS_CTL);
    for (int u = F.tid; u < (LDS_BYTES - LDSCTL_OFF) / 4; u += NWAVES * 64) ((LAS unsigned*)(F.lds + LDSCTL_OFF))[u] = 0u;
    __syncthreads();
    const int lo = args.ph_lo, hi = args.ph_hi;
    XcdBarrier bar; bar.bar = (unsigned*)(F.ctl + CW_BAR) + args.li * XCD_BAR_WORDS; bar.x = 0; bar.st = nullptr;
    if (hi - lo > 1) bar = xcd_barrier_post((unsigned*)(F.ctl + CW_BAR) + args.li * XCD_BAR_WORDS, F.MISC + 8);
#define IN(k) (lo <= (k) && (k) < hi)
#define GRID_BAR(k) do { if ((k) + 1 < hi) xcd_barrier(bar); } while (0)

    Args a;
#pragma unroll
    for (int i = 0; i < 25; ++i) a.in[i] = args.in[i];
    a.out = args.out; a.ws = ws; a.ph_lo = lo; a.ph_hi = hi;

    if (IN(0)) { REP(0) { phase_pro_a(F, a); } GRID_BAR(0); }
    if (IN(1)) { REP(1) { phase_pro_b(F, a); } GRID_BAR(1); }

    layer_body<0>(F, a, lo, hi, bar);
    layer_body<1>(F, a, lo, hi, bar);
#if defined(PROBE_XBAR)
    for (int i_ = 0; i_ < PROBE_XBAR; ++i_) xcd_barrier(bar);
#endif
#undef IN
#undef GRID_BAR
}
#define HOST_PLAN \
    MEGA(0, 22);
static int g_grid = 0;
static void launch_mega(const KArgs& base, int lo, int hi, int& li, hipStream_t stream) {
    KArgs a = base; a.ph_lo = lo; a.ph_hi = hi; a.li = li++; a.pad = 0;
    hipLaunchKernelGGL(mega, dim3(g_grid), dim3(NWAVES * 64), LDS_BYTES, stream, a);
}
extern "C" void kernel_launch(void* const* d_in, const int* in_sizes, int n_in, void* d_out, int out_size, void* d_ws, size_t ws_size, hipStream_t stream) {
    if (n_in != 25 || out_size != T * D || ws_size < WS_END) { fprintf(stderr, "kernel_launch: unexpected sizes n_in %d out %d ws %zu (need %zu)\n", n_in, out_size, ws_size, (size_t)WS_END); return; }
    if (g_grid == 0) {
        int dev = 0, cus = 0;
        if (hipGetDevice(&dev) != hipSuccess || hipDeviceGetAttribute(&cus, hipDeviceAttributeMultiprocessorCount, dev) != hipSuccess) { g_grid = -1; return; }
        if (hipFuncSetAttribute((const void*)mega, hipFuncAttributeMaxDynamicSharedMemorySize, LDS_BYTES) != hipSuccess) { g_grid = -1; return; }
        int per_cu = 0; (void)hipOccupancyMaxActiveBlocksPerMultiprocessor(&per_cu, (const void*)mega, NWAVES * 64, LDS_BYTES); (void)hipGetLastError();
        g_grid = cus;
    }
    if (g_grid < 0) return;
    const float* x = (const float*)d_in[0];
    const float *ln1_g = (const float*)d_in[2], *ln1_b = (const float*)d_in[3], *ln2_g = (const float*)d_in[4], *ln2_b = (const float*)d_in[5];
    const float *ret_gn = (const float*)d_in[10];
    const float *lq1 = (const float*)d_in[13], *lk1 = (const float*)d_in[14], *lq2 = (const float*)d_in[15], *lk2 = (const float*)d_in[16], *subg = (const float*)d_in[17];
    const float *bgrp = (const float*)d_in[19], *brt = (const float*)d_in[21];
    unsigned char* ws = (unsigned char*)d_ws; float* out = (float*)d_out;
    unsigned* ctl = (unsigned*)(ws + WS_CTL); float* mod = (float*)(ws + WS_MOD); float* WrT = (float*)(ws + WS_WRT);
    bf16_t *U = (bf16_t*)(ws + WS_U), *MIX = (bf16_t*)(ws + WS_MIX), *PROJ = (bf16_t*)(ws + WS_BIG), *XS = (bf16_t*)(ws + WS_XS);
    int* tok_e = (int*)(ws + WS_ROUTE + RT_TOKE); float* tok_g = (float*)(ws + WS_ROUTE + RT_TOKG); int* tok_rank = (int*)(ws + WS_ROUTE + RT_RANK); int* tok_slot = (int*)(ws + WS_ROUTE + RT_SLOT); int* tile_tab = (int*)(ws + WS_ROUTE + RT_TILE);
    (void)hipMemsetAsync(ws + WS_CTL, 0, CTL_ZERO_BYTES, stream);
    KArgs ka{}; for (int i = 0; i < 25; ++i) ka.in[i] = (const float*)d_in[i]; ka.out = out; ka.ws = ws;
    int li = 0;
#define MEGA(lo, hi) launch_mega(ka, lo, hi, li, stream)
    HOST_PLAN
#undef MEGA
}
```

```cpp
#include <hip/hip_runtime.h>
#include <stdint.h>
#include <stdio.h>

constexpr int D = 1024, BATCH = 4, SEQ = 8192, T = BATCH * SEQ, DEPTH = 2;
constexpr int EVEN_IN = 3584, ODD_IN = 3072;
constexpr int NEXP = 32, FF = 512, NGRP = 4, EPG = 8;
constexpr int PMAX = 2 * T + NEXP * 256;
constexpr int NTILE_MAX = PMAX / 256;
constexpr float LN_EPS = 1e-5f;
constexpr float ALPHA = 1.41421356237309515f;
constexpr float LOG2E = 1.4426950408889634f;
constexpr float LAMBDA_INIT1 = 0.35550906759f;

constexpr int P0_SQ = 0, P0_SK = 512, P0_SV = 1024, P0_RQ = 1536, P0_RK = 2048, P0_RV = 2560, P0_RG = 3072;
constexpr int P1_Q = 0, P1_K = 1024, P1_V = 2048;

constexpr size_t MiB = 1u << 20;
constexpr size_t WS_CTL = 0, CTL_ZERO_BYTES = 1 * MiB;
constexpr size_t WS_MODP = 1 * MiB;
constexpr size_t WS_MOD = 3 * MiB;
constexpr size_t WS_ROUTE = 4 * MiB;
constexpr size_t WS_KN = 5 * MiB + 64 * 1024;
constexpr size_t WS_WRT = 6 * MiB;
constexpr size_t WS_WIN0 = 8 * MiB, WS_WIN1 = 15 * MiB, WS_WOUT0 = 21 * MiB, WS_WOUT1 = 23 * MiB;
constexpr size_t WS_W13 = 26 * MiB;
constexpr size_t WS_W2 = 154 * MiB;
constexpr size_t WS_U = 218 * MiB;
constexpr size_t WS_MIX = 282 * MiB;
constexpr size_t WS_BIG = 346 * MiB;
constexpr size_t WS_XS = WS_BIG, WS_H = WS_BIG + 144 * MiB;
constexpr size_t WS_STATS = WS_BIG;
constexpr size_t WS_INV = WS_BIG + 80 * MiB;
constexpr size_t WS_ZROW = 768 * 1024;
constexpr size_t WS_Y = WS_U;
constexpr size_t WS_U2 = WS_MIX;
constexpr size_t WS_END = 570 * MiB;
constexpr size_t RT_TOKE = 0;
constexpr size_t RT_TOKG = 256 * 1024;
constexpr size_t RT_RANK = 512 * 1024;
constexpr size_t RT_SLOT = 768 * 1024;
constexpr size_t RT_TILE = 1024 * 1024;
constexpr int CW_TMO = 0, CW_CODE = 1;
constexpr int CW_CNT = 1024;
constexpr int CW_QDIFF = 65536;
constexpr int CW_QDIFF_OLD = 7424;
constexpr int CW_TCTR = 98304;
constexpr int CW_TT = 131072;
constexpr int CW_KNA = 163840;
constexpr int CW_BGQ = 99328;
constexpr int CW_BGDONE = 99392;
constexpr int CW_BAR = 8192;

typedef unsigned short bf16_t;
__device__ __forceinline__ float bf2f(bf16_t v) { return __uint_as_float((unsigned)v << 16); }
__device__ __forceinline__ unsigned f2bf(float f) { unsigned u = __float_as_uint(f); return (u + 0x7fffu + ((u >> 16) & 1u)) >> 16; }
__device__ __forceinline__ unsigned pk2(float lo, float hi) { return f2bf(lo) | (f2bf(hi) << 16); }
__device__ __forceinline__ float wave_sum(float v) {
#pragma unroll
    for (int o = 1; o < 64; o <<= 1) v += __shfl_xor(v, o);
    return v;
}
__device__ __forceinline__ float silu_f(float v) { return v / (1.f + __expf(-v)); }
#define GAS __attribute__((address_space(1)))
#define LAS __attribute__((address_space(3)))
typedef unsigned v4u __attribute__((ext_vector_type(4)));
typedef unsigned v2u __attribute__((ext_vector_type(2)));
typedef float f32x4 __attribute__((ext_vector_type(4)));
typedef float f32x16 __attribute__((ext_vector_type(16)));
typedef short bf16x8 __attribute__((ext_vector_type(8)));
typedef short s16x4 __attribute__((ext_vector_type(4)));
typedef GAS unsigned gu32;
typedef GAS unsigned long long gu64;
#define RLX_AGENT __ATOMIC_RELAXED, __HIP_MEMORY_SCOPE_AGENT
#define LDS_WAIT() asm volatile("s_waitcnt lgkmcnt(0)" ::: "memory")
#define VM_WAIT() asm volatile("s_waitcnt vmcnt(0)" ::: "memory")
__device__ __forceinline__ unsigned cvtpk_c(float lo, float hi) { unsigned r; asm("v_cvt_pk_bf16_f32 %0, %1, %2" : "=v"(r) : "v"(lo), "v"(hi)); return r; }
#ifndef PG8_WGM
#define PG8_WGM 8
#endif
namespace pg8 {
#define PG8_LAS __attribute__((address_space(3)))
typedef short bf16x8 __attribute__((ext_vector_type(8)));
typedef float f32x4 __attribute__((ext_vector_type(4)));
typedef unsigned u32x4 __attribute__((ext_vector_type(4)));
constexpr int BM = 256, BK = 64, HALF = 128, HTB = HALF * BK * 2  , STAGE_BYTES = 8 * HTB, NXCD = 8, WGM = PG8_WGM;

__host__ __device__ __forceinline__ int lds_byte(int r, int c) { const int st = (r >> 4) * 2 + (c >> 5), rr = r & 15, cc = c & 31, ob = rr * 64 + cc * 2; return st * 1024 + (ob ^ (((ob >> 9) & 1) << 5)); }
__host__ __device__ __forceinline__ void stage_rc(int b, int& R, int& C) { const int st = b / 1024, sb = b % 1024, swz = sb ^ (((sb >> 9) & 1) << 5); R = (st >> 1) * 16 + swz / 64; C = (st & 1) * 32 + (swz % 64) / 2; }
__host__ __device__ __forceinline__ int perm32(int rho) { const int n = rho >> 4, i = rho & 15; return 8 * (i >> 2) + 4 * n + (i & 3); }

struct Unit { int pm, pn; };
struct Gemm { const bf16_t* A; const bf16_t* Bt; int M, N, K; };

struct StaticOrder {
    int nM, nN, nwg, G, c;
    __host__ __device__ void init(int M, int N, int G_, int c_) { nM = M / BM; nN = N / BM; nwg = nM * nN; G = G_; c = c_; }
    __host__ __device__ bool next(int i, Unit& u) const {
        const long L = (long)i * G + c; if (L >= nwg) return false;
        int wgid = (int)L; { const int q = nwg / NXCD, r = nwg % NXCD, xcd = wgid % NXCD, off = wgid / NXCD; wgid = (xcd < r ? xcd * (q + 1) : r * (q + 1) + (xcd - r) * q) + off; }
        const int nig = WGM * nN, gid = wgid / nig, fm = gid * WGM, gsz = (nM - fm) < WGM ? (nM - fm) : WGM;
        u.pm = fm + ((wgid % nig) % gsz); u.pn = (wgid % nig) / gsz; return true;
    }
    __device__ __forceinline__ void a_ready(const Unit&) const {}
    __device__ __forceinline__ void done(const Unit&) const {}
};
__device__ __forceinline__ unsigned cvt_pk_bf16(float lo, float hi) { unsigned r; asm volatile("v_cvt_pk_bf16_f32 %0, %1, %2" : "=v"(r) : "v"(lo), "v"(hi)); return r; }
struct EpiStoreBf16 {
    static constexpr bool PERM = true, AFTER_DRAIN = false;
    bf16_t* O; int ldc; int pnmask;
    __device__ __forceinline__ void operator()(const f32x4 (&acc)[2][2][4][2], const Unit& u, int wr, int wc, int fr, int fq) const {
        const int row0 = u.pm * BM + wr * 64 + fr, col0 = (u.pn & pnmask) * BM + wc * 32 + 8 * fq;
#if defined(PROBE_EPI2)
        for (int rep_ = 0; rep_ < 2; ++rep_) { asm volatile("" ::: "memory");
#endif
#pragma unroll
        for (int ai = 0; ai < 2; ++ai)
#pragma unroll
            for (int m = 0; m < 4; ++m) { bf16_t* rowp = O + (size_t)(row0 + ai * HALF + m * 16) * ldc + col0;
#pragma unroll
                for (int bj = 0; bj < 2; ++bj) { const f32x4 v0 = acc[ai][bj][m][0], v1 = acc[ai][bj][m][1];
                    u32x4 w; w.x = cvt_pk_bf16(v0[0], v0[1]); w.y = cvt_pk_bf16(v0[2], v0[3]); w.z = cvt_pk_bf16(v1[0], v1[1]); w.w = cvt_pk_bf16(v1[2], v1[3]);
                    *(u32x4*)(rowp + bj * HALF) = w; } }
#if defined(PROBE_EPI2)
        }
#endif
    }
};
struct EpiProj1 {
    static constexpr bool PERM = true, AFTER_DRAIN = false;
    bf16_t* O; int ldc; unsigned* kna;
    __device__ __forceinline__ void operator()(const f32x4 (&acc)[2][2][4][2], const Unit& u, int wr, int wc, int fr, int fq) const {
        const int row0 = u.pm * BM + wr * 64 + fr, col0 = u.pn * BM + wc * 32 + 8 * fq;
        const bool isk = (u.pn >= 4) && (u.pn < 8);
#pragma unroll
        for (int ai = 0; ai < 2; ++ai) {
            float mx[2] = {0.f, 0.f};
#pragma unroll
            for (int m = 0; m < 4; ++m) { bf16_t* rowp = O + (size_t)(row0 + ai * HALF + m * 16) * ldc + col0;
#pragma unroll
                for (int bj = 0; bj < 2; ++bj) { const f32x4 v0 = acc[ai][bj][m][0], v1 = acc[ai][bj][m][1];
                    u32x4 w; w.x = cvt_pk_bf16(v0[0], v0[1]); w.y = cvt_pk_bf16(v0[2], v0[3]); w.z = cvt_pk_bf16(v1[0], v1[1]); w.w = cvt_pk_bf16(v1[2], v1[3]);
                    *(u32x4*)(rowp + bj * HALF) = w;
                    if (isk) {
                        const float r0 = __uint_as_float(w.x << 16), r1 = __uint_as_float(w.x & 0xffff0000u), r2 = __uint_as_float(w.y << 16), r3 = __uint_as_float(w.y & 0xffff0000u);
                        const float r4 = __uint_as_float(w.z << 16), r5 = __uint_as_float(w.z & 0xffff0000u), r6 = __uint_as_float(w.w << 16), r7 = __uint_as_float(w.w & 0xffff0000u);
                        float ss = ((r0 * r0 + r1 * r1) + (r2 * r2 + r3 * r3)) + ((r4 * r4 + r5 * r5) + (r6 * r6 + r7 * r7));
                        ss += __shfl_xor(ss, 16); ss += __shfl_xor(ss, 32);
                        mx[bj] = fmaxf(mx[bj], ss); } } }
            if (isk) {
#pragma unroll
                for (int bj = 0; bj < 2; ++bj) { float v = mx[bj];
                    v = fmaxf(v, __shfl_xor(v, 1)); v = fmaxf(v, __shfl_xor(v, 2)); v = fmaxf(v, __shfl_xor(v, 4)); v = fmaxf(v, __shfl_xor(v, 8));
                    if (fr == 0 && fq == 0) { const int grow = u.pm * BM + ai * HALF + wr * 64, b = grow >> 13, tile = (grow & 8191) >> 6, hm = 4 * (u.pn - 4) + 2 * bj + (wc >> 1);
                        atomicMax(kna + (((size_t)b * 16 + hm) * 128 + tile) * 2 + (wc & 1), __float_as_uint(v * 1.0001f)); } } }
        }
    }
};
template <bool XB> struct EpiOut {
    static constexpr bool PERM = true, AFTER_DRAIN = false;
    bf16_t* Y; const void* Xin; const float* g1; float* stats;
    __device__ __forceinline__ void operator()(const f32x4 (&acc)[2][2][4][2], const Unit& u, int wr, int wc, int fr, int fq) const {
        const int row0 = u.pm * BM + wr * 64 + fr, col0 = u.pn * BM + wc * 32 + 8 * fq;
        const float* g = g1 + (size_t)((u.pm * BM) / 8192) * 6144 + col0;
        f32x4 gv[2][2];
#pragma unroll
        for (int bj = 0; bj < 2; ++bj)
#pragma unroll
            for (int n = 0; n < 2; ++n) gv[bj][n] = *(const f32x4*)(g + bj * HALF + 4 * n) + 1.0f;
#pragma unroll
        for (int ai = 0; ai < 2; ++ai)
#pragma unroll
            for (int m = 0; m < 4; ++m) { const int row = row0 + ai * HALF + m * 16; const size_t off = (size_t)row * 1024 + col0; float s1 = 0.f, s2 = 0.f;
#pragma unroll
                for (int bj = 0; bj < 2; ++bj) {
                    f32x4 x0, x1;
                    if (XB) { const u32x4 xv = *(const u32x4*)((const bf16_t*)Xin + off + bj * HALF);
                        x0 = (f32x4){__uint_as_float(xv.x << 16), __uint_as_float(xv.x & 0xffff0000u), __uint_as_float(xv.y << 16), __uint_as_float(xv.y & 0xffff0000u)};
                        x1 = (f32x4){__uint_as_float(xv.z << 16), __uint_as_float(xv.z & 0xffff0000u), __uint_as_float(xv.w << 16), __uint_as_float(xv.w & 0xffff0000u)}; }
                    else { x0 = *(const f32x4*)((const float*)Xin + off + bj * HALF); x1 = *(const f32x4*)((const float*)Xin + off + bj * HALF + 4); }
                    const f32x4 y0 = x0 * 1.41421356237309515f + gv[bj][0] * acc[ai][bj][m][0], y1 = x1 * 1.41421356237309515f + gv[bj][1] * acc[ai][bj][m][1];
                    u32x4 w; w.x = cvt_pk_bf16(y0[0], y0[1]); w.y = cvt_pk_bf16(y0[2], y0[3]); w.z = cvt_pk_bf16(y1[0], y1[1]); w.w = cvt_pk_bf16(y1[2], y1[3]);
                    *(u32x4*)(Y + off + bj * HALF) = w;
                    const float r0 = __uint_as_float(w.x << 16), r1 = __uint_as_float(w.x & 0xffff0000u), r2 = __uint_as_float(w.y << 16), r3 = __uint_as_float(w.y & 0xffff0000u);
                    const float r4 = __uint_as_float(w.z << 16), r5 = __uint_as_float(w.z & 0xffff0000u), r6 = __uint_as_float(w.w << 16), r7 = __uint_as_float(w.w & 0xffff0000u);
                    s1 += ((r0 + r1) + (r2 + r3)) + ((r4 + r5) + (r6 + r7)); s2 += ((r0 * r0 + r1 * r1) + (r2 * r2 + r3 * r3)) + ((r4 * r4 + r5 * r5) + (r6 * r6 + r7 * r7)); }
                s1 += __shfl_xor(s1, 16); s2 += __shfl_xor(s2, 16); s1 += __shfl_xor(s1, 32); s2 += __shfl_xor(s2, 32);
                if (fq == 0) { typedef float f32x2e __attribute__((ext_vector_type(2))); *(f32x2e*)(stats + ((size_t)row * 16 + u.pn * 4 + wc) * 2) = (f32x2e){s1, s2}; } }
    }
};
struct EpiMoe1 {
    static constexpr bool PERM = true, AFTER_DRAIN = false;
    bf16_t* Hh;
    __device__ __forceinline__ void operator()(const f32x4 (&acc)[2][2][4][2], const Unit& u, int wr, int wc, int fr, int fq) const {
        const int row0 = u.pm * BM + wr * 64 + fr, col0 = (u.pn & 3) * HALF + wc * 32 + 8 * fq;
#pragma unroll
        for (int ai = 0; ai < 2; ++ai)
#pragma unroll
            for (int m = 0; m < 4; ++m) { bf16_t* rowp = Hh + (size_t)(row0 + ai * HALF + m * 16) * 512 + col0;
                float h[8];
#pragma unroll
                for (int n = 0; n < 2; ++n)
#pragma unroll
                    for (int i = 0; i < 4; ++i) { const float a = acc[ai][0][m][n][i], b = acc[ai][1][m][n][i]; h[n * 4 + i] = a * b * __builtin_amdgcn_rcpf(1.f + __builtin_amdgcn_exp2f(-1.4426950408889634f * a)); }
                u32x4 w; w.x = cvt_pk_bf16(h[0], h[1]); w.y = cvt_pk_bf16(h[2], h[3]); w.z = cvt_pk_bf16(h[4], h[5]); w.w = cvt_pk_bf16(h[6], h[7]);
                *(u32x4*)rowp = w; }
    }
};
struct MoeOrder {
    const PG8_LAS int* tt; int ntiles, G, c;
    __device__ __forceinline__ void init(const PG8_LAS int* tt_, int G_, int c_) { tt = tt_; ntiles = __builtin_amdgcn_readfirstlane(tt_[511]); G = G_; c = c_; }
    __device__ __forceinline__ bool next(int i, Unit& u) const {
        const int L = i * G + c; if (L >= ntiles * 4) return false;
        const int pm = L >> 2; const int e = __builtin_amdgcn_readfirstlane(tt[pm]); u.pm = pm; u.pn = e * 4 + (L & 3); return true;
    }
    __device__ __forceinline__ void a_ready(const Unit&) const {}
    __device__ __forceinline__ void done(const Unit&) const {}
};
template <class Epi, class Sched, bool ALIGN_EPI = false, bool SP2 = false, bool GATHER = false>
__device__ __forceinline__ void gemm_phase(PG8_LAS unsigned char* lds, const Gemm g, const Sched& S, const Epi& E, const PG8_LAS unsigned* goff = nullptr) {
    static_assert(!GATHER || SP2, "gather is wired into the SP2 loop only");
    int tid_l = threadIdx.x; asm volatile("" : "+v"(tid_l));
    const int tid = tid_l, wid = __builtin_amdgcn_readfirstlane(tid >> 6), lane = tid & 63, wr = wid >> 2, wc = wid & 3, fr = lane & 15, fq = lane >> 4;
    const int K = g.K, nt = K / BK;
    unsigned voffA[2], voffB[2];
#pragma unroll
    for (int i = 0; i < 2; ++i) { int R, C; stage_rc(tid * 16 + i * 8192, R, C); const int Rb = Epi::PERM ? ((R & ~31) + perm32(R & 31)) : R;
        voffA[i] = (unsigned)(R * K + C) * 2u; voffB[i] = (unsigned)(Rb * K + C) * 2u; }
    int gRow[2]; unsigned gCol[2];
#pragma unroll
    for (int i = 0; i < 2; ++i) { int R, C; stage_rc(tid * 16 + i * 8192, R, C); gRow[i] = R; gCol[i] = (unsigned)C * 2u; }
    unsigned gA[2][2] = {{0u, 0u}, {0u, 0u}}, gAn[2][2] = {{0u, 0u}, {0u, 0u}};
#define PG8_GLOAD(dst, u_) do { _Pragma("unroll") for (int h_ = 0; h_ < 2; ++h_) _Pragma("unroll") for (int i_ = 0; i_ < 2; ++i_) dst[h_][i_] = goff[(u_) * 256 + h_ * 128 + gRow[i_]] + gCol[i_]; } while (0)
    const size_t kstep = (size_t)(BK * 2);
    const size_t hstep = (size_t)HALF * K * 2;
    const size_t tstep = 2 * hstep;
    const unsigned ldsw = (unsigned)wid * 1024u;
    const int aoff = lds_byte(wr * 64 + fr, fq * 8), boff = lds_byte(wc * 32 + fr, fq * 8);
#define PG8_SA(b, h) (((b) * 2 + (h)) * HTB)
#define PG8_SB(b, h) ((4 + (b) * 2 + (h)) * HTB)
#define PG8_STAGE(bufoff, gbase, voff) do { _Pragma("unroll") for (int _i = 0; _i < 2; ++_i) \
        __builtin_amdgcn_global_load_lds((const unsigned*)((const char*)(gbase) + (voff)[_i]), (PG8_LAS unsigned*)(lds + (bufoff) + ldsw + _i * 8192), 16, 0, 0); } while (0)
#define PG8_STAGE_A(bufoff, ptr, h, nx) do { if constexpr (GATHER) { unsigned vo_[2]; vo_[0] = (nx) ? gAn[h][0] : gA[h][0]; vo_[1] = (nx) ? gAn[h][1] : gA[h][1]; PG8_STAGE(bufoff, ptr, vo_); } \
        else PG8_STAGE(bufoff, (ptr) + (h) * hstep, voffA); } while (0)
#define PG8_LDA(dst, b, h) do { _Pragma("unroll") for (int m = 0; m < 4; ++m) _Pragma("unroll") for (int k = 0; k < 2; ++k) dst[m][k] = *(const PG8_LAS bf16x8*)(lds + PG8_SA(b, h) + aoff + m * 2048 + k * 1024); } while (0)
#define PG8_LDB(dst, b, h) do { _Pragma("unroll") for (int n = 0; n < 2; ++n) _Pragma("unroll") for (int k = 0; k < 2; ++k) dst[n][k] = *(const PG8_LAS bf16x8*)(lds + PG8_SB(b, h) + boff + n * 2048 + k * 1024); } while (0)
#define PG8_MMA(ai, bj, At, Bt) do { __builtin_amdgcn_s_setprio(1); _Pragma("unroll") for (int m = 0; m < 4; ++m) _Pragma("unroll") for (int n = 0; n < 2; ++n) _Pragma("unroll") for (int k = 0; k < 2; ++k) \
        acc[ai][bj][m][n] = __builtin_amdgcn_mfma_f32_16x16x32_bf16(Bt[n][k], At[m][k], acc[ai][bj][m][n], 0, 0, 0); __builtin_amdgcn_s_setprio(0); } while (0)
#define PG8_WAIT_V(n) asm volatile("s_waitcnt vmcnt(" #n ")" ::: "memory")
#define PG8_WAIT_L(n) asm volatile("s_waitcnt lgkmcnt(" #n ")" ::: "memory")
#define PG8_BAR __builtin_amdgcn_s_barrier()
#define PG8_SCHED __builtin_amdgcn_sched_barrier(0)
    Unit cur, nxt; int ui = 0;
    if (!S.next(0, cur)) return;
    f32x4 acc[2][2][4][2];
#pragma unroll
    for (int a = 0; a < 2; ++a)
#pragma unroll
        for (int b = 0; b < 2; ++b)
#pragma unroll
            for (int m = 0; m < 4; ++m)
#pragma unroll
                for (int n = 0; n < 2; ++n) acc[a][b][m][n] = (f32x4){0.f, 0.f, 0.f, 0.f};
    bf16x8 At[4][2], B0[2][2], B1[2][2];
    const char* cA = (const char*)g.A + (GATHER ? (size_t)0 : (size_t)cur.pm * tstep); const char* cB = (const char*)g.Bt + (size_t)cur.pn * tstep;
    if constexpr (GATHER) PG8_GLOAD(gA, 0);
    S.a_ready(cur);
    if constexpr (SP2) {
        PG8_STAGE(PG8_SB(0, 0), cB, voffB); PG8_STAGE(PG8_SB(0, 1), cB + hstep, voffB); PG8_STAGE_A(PG8_SA(0, 0), cA, 0, false); PG8_STAGE_A(PG8_SA(0, 1), cA, 1, false);
        if (wr == 1) PG8_BAR;
        PG8_WAIT_V(2); PG8_BAR;
        PG8_STAGE(PG8_SB(1, 0), cB + kstep, voffB); PG8_STAGE_A(PG8_SA(1, 0), cA + kstep, 0, false); PG8_STAGE(PG8_SB(1, 1), cB + hstep + kstep, voffB);
        PG8_WAIT_V(6); PG8_BAR;
    } else {
        PG8_STAGE(PG8_SB(0, 0), cB, voffB); PG8_STAGE(PG8_SA(0, 0), cA, voffA); PG8_STAGE(PG8_SB(0, 1), cB + hstep, voffB); PG8_STAGE(PG8_SA(0, 1), cA + hstep, voffA);
        if (wr == 1) PG8_BAR;
        PG8_WAIT_V(4); PG8_BAR;
        PG8_STAGE(PG8_SB(1, 0), cB + kstep, voffB); PG8_STAGE(PG8_SA(1, 0), cA + kstep, voffA); PG8_STAGE(PG8_SB(1, 1), cB + hstep + kstep, voffB);
        PG8_WAIT_V(6); PG8_BAR;
    }
    for (;;) {
        const bool has_next = S.next(ui + 1, nxt);
        if constexpr (GATHER) { if (has_next) PG8_GLOAD(gAn, ui + 1); }
        const char* nA = (has_next && !GATHER) ? (const char*)g.A + (size_t)nxt.pm * tstep : cA; const char* nB = has_next ? (const char*)g.Bt + (size_t)nxt.pn * tstep : cB;
        for (int t = 0; t < nt; t += 2) {
            const bool last = (t == nt - 2);
            const char* a1 = cA + (size_t)(t + 1) * kstep;
            const char* a2 = last ? nA : cA + (size_t)(t + 2) * kstep; const char* b2 = last ? nB : cB + (size_t)(t + 2) * kstep;
            const char* a3 = a2 + kstep; const char* b3 = b2 + kstep;
            if (last && has_next) S.a_ready(nxt);
            const bool nx = last && has_next;
            if constexpr (SP2) {
            PG8_LDB(B0, 0, 0); PG8_LDB(B1, 0, 1); PG8_SCHED; PG8_LDA(At, 0, 0); PG8_STAGE_A(PG8_SA(1, 1), a1, 1, false);
            PG8_WAIT_V(8); PG8_WAIT_L(0); PG8_BAR; PG8_MMA(0, 0, At, B0); PG8_MMA(0, 1, At, B1); PG8_BAR; PG8_SCHED;
            PG8_LDA(At, 0, 1); PG8_STAGE(PG8_SB(0, 0), b2, voffB); PG8_STAGE(PG8_SB(0, 1), b2 + hstep, voffB); PG8_STAGE_A(PG8_SA(0, 0), a2, 0, nx);
            PG8_WAIT_V(8); PG8_WAIT_L(0); PG8_BAR; PG8_MMA(1, 0, At, B0); PG8_MMA(1, 1, At, B1); PG8_BAR; PG8_SCHED;
            PG8_LDB(B0, 1, 0); PG8_LDB(B1, 1, 1); PG8_SCHED; PG8_LDA(At, 1, 0); PG8_STAGE_A(PG8_SA(0, 1), a2, 1, nx);
            PG8_WAIT_V(8); PG8_WAIT_L(0); PG8_BAR; PG8_MMA(0, 0, At, B0); PG8_MMA(0, 1, At, B1); PG8_BAR; PG8_SCHED;
            PG8_LDA(At, 1, 1); PG8_STAGE(PG8_SB(1, 0), b3, voffB); PG8_STAGE(PG8_SB(1, 1), b3 + hstep, voffB); PG8_STAGE_A(PG8_SA(1, 0), a3, 0, nx);
            PG8_WAIT_V(8); PG8_WAIT_L(0); PG8_BAR; PG8_MMA(1, 0, At, B0); PG8_MMA(1, 1, At, B1); PG8_BAR; PG8_SCHED;
            } else {
            PG8_LDB(B0, 0, 0); PG8_SCHED; PG8_LDA(At, 0, 0); PG8_STAGE(PG8_SA(1, 1), a1 + hstep, voffA);
            PG8_WAIT_L(8); PG8_BAR; PG8_WAIT_L(0); PG8_MMA(0, 0, At, B0); PG8_BAR; PG8_SCHED;
            PG8_LDB(B1, 0, 1); PG8_STAGE(PG8_SB(0, 0), b2, voffB);
            PG8_BAR; PG8_WAIT_L(0); PG8_MMA(0, 1, At, B1); PG8_BAR;
            PG8_LDA(At, 0, 1); PG8_STAGE(PG8_SA(0, 0), a2, voffA);
            PG8_BAR; PG8_WAIT_L(0); PG8_MMA(1, 0, At, B0); PG8_BAR; PG8_SCHED;
            PG8_STAGE(PG8_SB(0, 1), b2 + hstep, voffB);
            PG8_WAIT_V(6); PG8_BAR; PG8_MMA(1, 1, At, B1); PG8_BAR;
            PG8_LDB(B0, 1, 0); PG8_SCHED; PG8_LDA(At, 1, 0); PG8_STAGE(PG8_SA(0, 1), a2 + hstep, voffA);
            PG8_WAIT_L(8); PG8_BAR; PG8_WAIT_L(0); PG8_MMA(0, 0, At, B0); PG8_BAR; PG8_SCHED;
            PG8_LDB(B1, 1, 1); PG8_STAGE(PG8_SB(1, 0), b3, voffB);
            PG8_BAR; PG8_WAIT_L(0); PG8_MMA(0, 1, At, B1); PG8_BAR;
            PG8_LDA(At, 1, 1); PG8_STAGE(PG8_SA(1, 0), a3, voffA);
            PG8_BAR; PG8_WAIT_L(0); PG8_MMA(1, 0, At, B0); PG8_BAR; PG8_SCHED;
            PG8_STAGE(PG8_SB(1, 1), b3 + hstep, voffB);
            PG8_WAIT_V(6); PG8_BAR; PG8_MMA(1, 1, At, B1); PG8_BAR;
            }
        }
        if constexpr (ALIGN_EPI) { if (wr == 0) PG8_BAR; }
        if constexpr (!Epi::AFTER_DRAIN) { E(acc, cur, wr, wc, fr, fq); S.done(cur); }
        if (!has_next) break;
#pragma unroll
        for (int a = 0; a < 2; ++a)
#pragma unroll
            for (int b = 0; b < 2; ++b)
#pragma unroll
                for (int m = 0; m < 4; ++m)
#pragma unroll
                    for (int n = 0; n < 2; ++n) acc[a][b][m][n] = (f32x4){0.f, 0.f, 0.f, 0.f};
        cur = nxt; cA = nA; cB = nB; ++ui;
        if constexpr (GATHER) { _Pragma("unroll") for (int h_ = 0; h_ < 2; ++h_) _Pragma("unroll") for (int i_ = 0; i_ < 2; ++i_) gA[h_][i_] = gAn[h_][i_]; }
        if constexpr (ALIGN_EPI) { if (wr == 1) PG8_BAR; }
    }
    PG8_WAIT_V(0);
    if constexpr (!ALIGN_EPI) { if (wr == 0) PG8_BAR; }
    PG8_BAR;
    if constexpr (Epi::AFTER_DRAIN) { E.fused(acc, cur, wr, wc, fr, fq, lds, wid, lane); S.done(cur); }
#undef PG8_SA
#undef PG8_SB
#undef PG8_STAGE
#undef PG8_STAGE_A
#undef PG8_GLOAD
#undef PG8_LDA
#undef PG8_LDB
#undef PG8_MMA
#undef PG8_WAIT_V
#undef PG8_WAIT_L
#undef PG8_BAR
#undef PG8_SCHED
}
}
#define XB_TMO      128
#define XB_XCNT(j)  (256  + 64 * (j))
#define XB_XSUB(j)  (1280 + 64 * (j))
#define XB_XGEN(j)  (2304 + 64 * (j))
#define XB_TOP      3328
#define XB_TOPGEN   3392
#define XCD_BAR_WORDS 3456
#define XB_SPIN_CAP (1u << 18)

__device__ __forceinline__ unsigned xb_ld(unsigned* p)              { return __hip_atomic_load(p, __ATOMIC_RELAXED, __HIP_MEMORY_SCOPE_AGENT); }
__device__ __forceinline__ unsigned xb_add(unsigned* p, unsigned v) { return __hip_atomic_fetch_add(p, v, __ATOMIC_RELAXED, __HIP_MEMORY_SCOPE_AGENT); }
__device__ __forceinline__ unsigned xb_xcc_id() { return (unsigned)__builtin_amdgcn_s_getreg((3 << 11) | 20) & 0xFu; }
#define XB_SPIN(cond, bar) do { unsigned _sp = 0; while (cond) { __builtin_amdgcn_s_sleep(1); \
    if ((++_sp & 255u) == 0u) { if (xb_ld(&(bar)[XB_TMO])) break; if (_sp > XB_SPIN_CAP) { atomicAdd(&(bar)[XB_TMO], 1u); break; } } } } while (0)

struct XcdBarrier {
    unsigned* bar; unsigned x;
    volatile LAS unsigned* st;
};

__device__ __forceinline__ XcdBarrier xcd_barrier_post(unsigned* bar, volatile LAS unsigned* st) {
    XcdBarrier b; b.bar = bar; b.x = xb_xcc_id(); b.st = st;
    if (threadIdx.x == 0) (void)xb_add(&bar[XB_XCNT(b.x)], 1u);
    return b;
}
__device__ __forceinline__ void xcd_barrier_complete(unsigned* bar, unsigned x, unsigned& nloc, unsigned& nx) {
    const unsigned G = gridDim.x * gridDim.y * gridDim.z;
    unsigned sum, cnt, mine, sp = 0u;
    for (;;) {
        sum = 0u; cnt = 0u; mine = 0u;
#pragma unroll
        for (unsigned j = 0; j < 16; ++j) { const unsigned c = xb_ld(&bar[XB_XCNT(j)]); sum += c; cnt += (c > 0u) ? 1u : 0u; mine = (j == x) ? c : mine; }
        if (sum == G) break;
        __builtin_amdgcn_s_sleep(1);
        if ((++sp & 255u) == 0u) { if (xb_ld(&bar[XB_TMO])) break; if (sp > XB_SPIN_CAP) { atomicAdd(&bar[XB_TMO], 1u); break; } }
    }
    nloc = mine > 0u ? mine : 1u; nx = cnt > 0u ? cnt : 1u;
}

__device__ __forceinline__ void xcd_barrier(const XcdBarrier& b) {
    asm volatile("s_waitcnt vmcnt(0)" ::: "memory");
    __syncthreads();
    if (threadIdx.x == 0) {
        unsigned* bar = b.bar;
        __builtin_amdgcn_s_waitcnt(0);
        unsigned nloc = b.st[0], nx = b.st[1];
        if (nloc == 0u) { xcd_barrier_complete(bar, b.x, nloc, nx); b.st[0] = nloc; b.st[1] = nx; }
        const unsigned old = xb_add(&bar[XB_XSUB(b.x)], 1u);
        const unsigned gen = old / nloc;
        if (old + 1u == (gen + 1u) * nloc) {
            __builtin_amdgcn_fence(__ATOMIC_RELEASE, "agent");
            asm volatile("s_waitcnt vmcnt(0)" ::: "memory");
            const unsigned og = xb_add(&bar[XB_TOP], 1u);
            const unsigned tg = og / nx;
            if (og + 1u == (tg + 1u) * nx) xb_add(&bar[XB_TOPGEN], 1u);
            else XB_SPIN(xb_ld(&bar[XB_TOPGEN]) == tg, bar);
            __builtin_amdgcn_fence(__ATOMIC_ACQUIRE, "agent");
            xb_add(&bar[XB_XGEN(b.x)], 1u);
            asm volatile("s_waitcnt vmcnt(0)" ::: "memory");
        } else {
            XB_SPIN(xb_ld(&bar[XB_XGEN(b.x)]) == gen, bar);
            __builtin_amdgcn_fence(__ATOMIC_ACQUIRE, "agent");
            asm volatile("s_waitcnt vmcnt(0)" ::: "memory");
        }
    }
    __syncthreads();
}
constexpr int NWAVES = 8;
constexpr int RING_OFF = 0, RING_BYTES = 131072;
constexpr int LDSCTL_OFF = RING_BYTES, MISC_OFF = LDSCTL_OFF + 320;
constexpr int LDS_BYTES = 147456;
constexpr int TT_LDS_OFF = 132096;
constexpr int GOFF_LDS_OFF = TT_LDS_OFF + 4096, MOE_UMAX = 6;

struct Frame {
    LAS unsigned char* lds;
    volatile LAS unsigned* MISC;
    gu32* ctl;
    int tid, lane, wave, vcu, G;
};

__device__ __forceinline__ void transpose_item(const float* W, int N, bf16_t* WT, int K, int k0, int n0, int row0, float sc, LAS float* scr, int lane) {
    float v[32];
    const float* src = W + (size_t)(k0 + (lane >> 5)) * N + n0 + (lane & 31);
#pragma unroll
    for (int i = 0; i < 32; ++i) v[i] = __builtin_nontemporal_load(src + (size_t)(2 * i) * N);
#pragma unroll
    for (int i = 0; i < 32; ++i) scr[(2 * i + (lane >> 5)) * 33 + (lane & 31)] = v[i];
    LDS_WAIT(); asm volatile("" ::: "memory");
    const int c = lane & 7;
#pragma unroll
    for (int j = 0; j < 4; ++j) { const int n = (lane >> 3) + 8 * j; const LAS float* s = scr + (8 * c) * 33 + n;
        v4u o; o.x = cvtpk_c(s[0 * 33] * sc, s[1 * 33] * sc); o.y = cvtpk_c(s[2 * 33] * sc, s[3 * 33] * sc); o.z = cvtpk_c(s[4 * 33] * sc, s[5 * 33] * sc); o.w = cvtpk_c(s[6 * 33] * sc, s[7 * 33] * sc);
        *(GAS v4u*)(WT + (size_t)(row0 + n) * K + k0 + 8 * c) = o; }
    LDS_WAIT(); asm volatile("" ::: "memory");
}

struct Args {
    const float* in[25]; float* out; unsigned char* ws; int ph_lo, ph_hi;
};

__device__ __forceinline__ void moe_item(const Args& a, unsigned char* ws, int r, LAS float* scr, int lane) {
    constexpr int I_W1 = 16 * 16, I_W2 = 8 * 32;
    const int le = r / (2 * I_W1 + I_W2); int q = r % (2 * I_W1 + I_W2);
    if (q < 2 * I_W1) { const int which = q / I_W1; q %= I_W1; const int nb = q % 16, kb = q / 16, n0 = nb * 32;
        const float* W = a.in[which ? 23 : 22] + (size_t)le * D * FF;
        const int row0 = 256 * (n0 / 128) + 128 * which + (n0 % 128);
        transpose_item(W, FF, (bf16_t*)(ws + WS_W13) + (size_t)le * 1024 * 1024, D, kb * 64, n0, row0, 1.f, scr, lane); }
    else { q -= 2 * I_W1; const int nb = q % 32, kb = q / 32, n0 = nb * 32;
        transpose_item(a.in[24] + (size_t)le * FF * D, D, (bf16_t*)(ws + WS_W2) + (size_t)le * 1024 * 512, FF, kb * 64, n0, n0, 1.f, scr, lane); }
}
constexpr int BG_ITEMS = NEXP * 768, BG_CHUNKS = BG_ITEMS / 8;
__device__ __forceinline__ void bg_pump(Frame& F, const Args& a, const int seam) {
    unsigned char* ws = a.ws;
    LAS float* scr = (LAS float*)(F.lds + RING_OFF + F.wave * 16384);
    LAS int* w = (LAS int*)(F.lds + TT_LDS_OFF + 2048);
    gu32* head = F.ctl + CW_BGQ; gu32* done = F.ctl + CW_BGDONE + 64 * (seam < 0 ? 0 : seam);
    __syncthreads();
    if (F.tid == 0) { int go = 1;
        if (seam >= 0) { const unsigned d = __hip_atomic_fetch_add(done, 1u, RLX_AGENT); if (d + 1u >= (unsigned)F.G) go = 0; }
        w[0] = go ? (int)__hip_atomic_fetch_add(head, 1u, RLX_AGENT) : BG_CHUNKS; }
    __syncthreads();
    for (;;) {
        const int q = w[0];
        __syncthreads();
        if (q >= BG_CHUNKS) break;
        moe_item(a, ws, NEXP * 768 + q * 8 + F.wave, scr, F.lane);
        if (F.tid == 0) { int go = 1;
            if (seam >= 0 && __hip_atomic_load(done, RLX_AGENT) >= (unsigned)F.G) go = 0;
            w[0] = go ? (int)__hip_atomic_fetch_add(head, 1u, RLX_AGENT) : BG_CHUNKS; }
        __syncthreads();
    }
}
enum { PH_PRO_A = 0, PH_PRO_B, PH_L0_PROJ, PH_L0_MIXA, PH_L0_SCAN, PH_L0_MIXB, PH_L0_OUT, PH_L0_LNR, PH_L0_DISP, PH_L0_MOE1, PH_L0_MOE2, PH_L0_COMB,
       PH_L1_PROJ, PH_L1_ATT, PH_L1_OUT, PH_L1_LNR, PH_L1_DISP, PH_L1_MOE1, PH_L1_MOE2, PH_L1_COMB, PH_END };

__device__ __forceinline__ void phase_pro_a(Frame& F, const Args& a) {
    unsigned char* ws = a.ws;
    LAS float* scr = (LAS float*)(F.lds + RING_OFF + F.wave * 16384);
    const int gw = F.vcu * NWAVES + F.wave, NGW = F.G * NWAVES;
    constexpr int I_IN0 = 16 * (EVEN_IN / 32), I_IN1 = 16 * (ODD_IN / 32), I_OUT = 16 * 32, I_W1 = 16 * 16, I_W2 = 8 * 32;
    constexpr int I_MOE = 1 * NEXP * (2 * I_W1 + I_W2);
    constexpr int NITEMS = I_IN0 + I_IN1 + 2 * I_OUT + I_MOE;
    for (int it = gw; it < NITEMS; it += NGW) {
        int r = it;
        if (r < I_IN0) { const int nb = r % (EVEN_IN / 32), kb = r / (EVEN_IN / 32), n0 = nb * 32;
            const float sc = (n0 < 512) ? 0.125f * LOG2E : ((n0 >= P0_RK && n0 < P0_RV) ? 0.08838834764831845f : 1.f);
            transpose_item(a.in[8], EVEN_IN, (bf16_t*)(ws + WS_WIN0), D, kb * 64, n0, n0, sc, scr, F.lane); continue; } r -= I_IN0;
        if (r < I_IN1) { const int nb = r % (ODD_IN / 32), kb = r / (ODD_IN / 32), n0 = nb * 32;
            const float sc = (n0 < 1024) ? 0.125f * LOG2E : 1.f;
            transpose_item(a.in[11], ODD_IN, (bf16_t*)(ws + WS_WIN1), D, kb * 64, n0, n0, sc, scr, F.lane); continue; } r -= I_IN1;
        if (r < I_OUT) { const int nb = r % 32, kb = r / 32; transpose_item(a.in[9], D, (bf16_t*)(ws + WS_WOUT0), D, kb * 64, nb * 32, nb * 32, 1.f, scr, F.lane); continue; } r -= I_OUT;
        if (r < I_OUT) { const int nb = r % 32, kb = r / 32; transpose_item(a.in[12], D, (bf16_t*)(ws + WS_WOUT1), D, kb * 64, nb * 32, nb * 32, 1.f, scr, F.lane); continue; } r -= I_OUT;
        moe_item(a, ws, r, scr, F.lane);
    }
    float* modp = (float*)(ws + WS_MODP);
    for (int task = gw; task < 8 * 2 * 96; task += NGW) {
        const int ks = task / 192, l = (task / 96) % 2, n = (task % 96) * 64 + F.lane;
        const float* w = a.in[6] + ((size_t)l * D + ks * 128) * 6 * D + n; const float* c = a.in[1] + ks * 128;
        float a0 = 0, a1 = 0, a2 = 0, a3 = 0;
#pragma unroll 8
        for (int k = 0; k < 128; ++k) { const float wv = w[(size_t)k * 6 * D];
            a0 += silu_f(c[k]) * wv; a1 += silu_f(c[D + k]) * wv; a2 += silu_f(c[2 * D + k]) * wv; a3 += silu_f(c[3 * D + k]) * wv; }
        float* o = modp + ((size_t)(ks * 2 + l) * 4) * 6 * D + n;
        o[0] = a0; o[6 * D] = a1; o[2 * 6 * D] = a2; o[3 * 6 * D] = a3;
    }
    bf16_t* WrH = (bf16_t*)(ws + WS_WRT); bf16_t* WrL = WrH + DEPTH * 48 * D;
    for (int i = (F.vcu * NWAVES * 64 + F.tid); i < DEPTH * 48 * D; i += F.G * NWAVES * 64) {
        const int l = i / (48 * D), n = (i / D) % 48, k = i % D;
        const float w = (n < 4) ? a.in[18][((size_t)l * D + k) * 4 + n] : (n < 36 ? a.in[20][((size_t)l * D + k) * 32 + (n - 4)] : 0.f);
        const unsigned h = f2bf(w); WrH[i] = (bf16_t)h; WrL[i] = (bf16_t)f2bf(w - __uint_as_float(h << 16));
    }
}

__device__ __forceinline__ void phase_pro_b(Frame& F, const Args& a) {
    unsigned char* ws = a.ws;
    const float* modp = (const float*)(ws + WS_MODP); float* mod = (float*)(ws + WS_MOD);
    for (int i = F.vcu * NWAVES * 64 + F.tid; i < 2 * 4 * 6 * D; i += F.G * NWAVES * 64) {
        const int l = i / (4 * 6 * D), n = i % (6 * D);
        float s = a.in[7][l * 6 * D + n];
#pragma unroll
        for (int ks = 0; ks < 8; ++ks) s += modp[(size_t)ks * 2 * 4 * 6 * D + i];
        mod[i] = s;
    }
    LAS float* ms = (LAS float*)(F.lds + RING_OFF);
    for (int i = F.tid; i < 4 * 2 * D; i += NWAVES * 64) {
        const int b = i / (2 * D), n = i % (2 * D);
        float s = a.in[7][n];
#pragma unroll
        for (int ks = 0; ks < 8; ++ks) s += modp[((size_t)(ks * 2 + 0) * 4 + b) * 6 * D + n];
        ms[i] = s;
    }
    __syncthreads();
    const int gw = F.vcu * NWAVES + F.wave, NGW = F.G * NWAVES;
    bf16_t* U = (bf16_t*)(ws + WS_U);
    for (int blk = gw; blk < T / 16; blk += NGW) {
        const int row0 = blk * 16, b = row0 / SEQ;
        f32x4 ksh[4], ksc[4];
#pragma unroll
        for (int j = 0; j < 4; ++j) { const int c = 4 * F.lane + 256 * j; ksh[j] = *(const LAS f32x4*)(ms + b * 2 * D + c); ksc[j] = *(const LAS f32x4*)(ms + b * 2 * D + D + c) + 1.0f; }
#pragma unroll 4
        for (int i = 0; i < 16; ++i) { const int row = row0 + i; const GAS f32x4* xr = (const GAS f32x4*)(a.in[0] + (size_t)row * D) + F.lane;
#pragma unroll
            for (int j = 0; j < 4; ++j) { const f32x4 v = __builtin_nontemporal_load(xr + 64 * j); const f32x4 u = v * ksc[j] + ksh[j];
                ((GAS unsigned long long*)(U + (size_t)row * D))[F.lane + 64 * j] = (unsigned long long)cvtpk_c(u.x, u.y) | ((unsigned long long)cvtpk_c(u.z, u.w) << 32);
} }
    }
    __syncthreads();
}
__device__ __forceinline__ int opaque_i(int v) { asm volatile("" : "+v"(v)); return v; }

__device__ __forceinline__ void phase_lnr(Frame& F, const Args& a, const int l, const bool dry = false) {
    unsigned char* ws = a.ws; const bf16_t* Yb = (const bf16_t*)(ws + WS_Y); bf16_t* U2 = (bf16_t*)(ws + WS_U2); int* inv = (int*)(ws + WS_INV);
    const float* mod = (const float*)(ws + WS_MOD); const float* stats = (const float*)(ws + WS_STATS);
    int* tok_e = (int*)(ws + (dry ? WS_KN + 256 * 1024 : WS_ROUTE + RT_TOKE)); float* tok_g = (float*)(ws + (dry ? WS_KN + 512 * 1024 : WS_ROUTE + RT_TOKG)); int* tok_rank = (int*)(ws + (dry ? WS_KN + 768 * 1024 : WS_ROUTE + RT_RANK));
    unsigned* cnt = (unsigned*)(ws + WS_CTL) + (dry ? CW_CNT + 2 * 32 * 64 : CW_CNT + l * 32 * 64);
    const float* lng = a.in[2] + l * D; const float* lnb = a.in[3] + l * D; const float* bgrp = a.in[19] + l * 4; const float* brt = a.in[21] + l * 32;
    const bf16_t* WrH = (const bf16_t*)(ws + WS_WRT) + (size_t)l * 48 * D; const bf16_t* WrL = WrH + DEPTH * 48 * D;
    const int tid = opaque_i(F.tid), lane = tid & 63, wave = F.wave, r = lane & 15, kg = lane >> 4;
    LAS unsigned char* lds = F.lds + RING_OFF;
    LAS float* LG = (LAS float*)lds + wave * (16 * 49);
    LAS unsigned* hist = (LAS unsigned*)(lds + 32768);
    LAS int* pend = (LAS int*)(lds + 32768 + 256);
    LAS float* coef = (LAS float*)(lds + 40960);
    typedef float f32x4m __attribute__((ext_vector_type(4)));
    for (int tile = F.vcu; tile < T / 128; tile += F.G) {
        const int row0 = tile * 128 + wave * 16, row = row0 + r, b = row0 / SEQ;
        const float* m = mod + (size_t)(l * 4 + b) * 6 * D;
        if (tid < 64) hist[tid] = 0u;
        for (int i = tid; i < 1024; i += NWAVES * 64) { coef[i] = lng[i]; coef[1024 + i] = lnb[i]; coef[2048 + i] = 1.0f + m[4 * D + i]; coef[3072 + i] = m[3 * D + i]; }
        float mean, rstd;
        { typedef float f32x2e __attribute__((ext_vector_type(2))); const f32x2e* sp = (const f32x2e*)(stats + ((size_t)row * 16 + kg * 4) * 2);
          float s1 = (sp[0].x + sp[1].x) + (sp[2].x + sp[3].x), s2 = (sp[0].y + sp[1].y) + (sp[2].y + sp[3].y);
          s1 += __shfl_xor(s1, 16); s2 += __shfl_xor(s2, 16); s1 += __shfl_xor(s1, 32); s2 += __shfl_xor(s2, 32);
          mean = s1 * (1.f / D); rstd = rsqrtf(fmaxf(s2 * (1.f / D) - mean * mean, 0.f) + LN_EPS); }
        const bf16_t* yrow = Yb + (size_t)row * D + 8 * kg; bf16_t* u2row = U2 + (size_t)row * D + 8 * kg;
        const bf16_t* wh = WrH + (size_t)r * D + 8 * kg; const bf16_t* wl = WrL + (size_t)r * D + 8 * kg;
        f32x4m acc0 = {0.f, 0.f, 0.f, 0.f}, acc1 = acc0, acc2 = acc0;
        __syncthreads();
#pragma unroll 8
        for (int c = 0; c < 32; ++c) {
            const int k = c * 32;
            const v4u yv = *(const GAS v4u*)(yrow + k);
            const f32x4 y0 = {__uint_as_float(yv.x << 16), __uint_as_float(yv.x & 0xffff0000u), __uint_as_float(yv.y << 16), __uint_as_float(yv.y & 0xffff0000u)}, y1 = {__uint_as_float(yv.z << 16), __uint_as_float(yv.z & 0xffff0000u), __uint_as_float(yv.w << 16), __uint_as_float(yv.w & 0xffff0000u)};
            const int kc = k + 8 * kg;
            const f32x4 g0 = *(const LAS f32x4*)(coef + kc), g1 = *(const LAS f32x4*)(coef + kc + 4), b0 = *(const LAS f32x4*)(coef + 1024 + kc), b1 = *(const LAS f32x4*)(coef + 1024 + kc + 4);
            const f32x4 c0 = *(const LAS f32x4*)(coef + 2048 + kc), c1 = *(const LAS f32x4*)(coef + 2048 + kc + 4), h0 = *(const LAS f32x4*)(coef + 3072 + kc), h1 = *(const LAS f32x4*)(coef + 3072 + kc + 4);
            const f32x4 x0 = (y0 - mean) * rstd * g0 + b0, x1 = (y1 - mean) * rstd * g1 + b1;
            const f32x4 u0 = x0 * c0 + h0, u1 = x1 * c1 + h1;
            v4u uh; uh.x = cvtpk_c(u0.x, u0.y); uh.y = cvtpk_c(u0.z, u0.w); uh.z = cvtpk_c(u1.x, u1.y); uh.w = cvtpk_c(u1.z, u1.w);
            v4u ul;
            ul.x = cvtpk_c(u0.x - __uint_as_float(uh.x << 16), u0.y - __uint_as_float(uh.x & 0xffff0000u)); ul.y = cvtpk_c(u0.z - __uint_as_float(uh.y << 16), u0.w - __uint_as_float(uh.y & 0xffff0000u));
            ul.z = cvtpk_c(u1.x - __uint_as_float(uh.z << 16), u1.y - __uint_as_float(uh.z & 0xffff0000u)); ul.w = cvtpk_c(u1.z - __uint_as_float(uh.w << 16), u1.w - __uint_as_float(uh.w & 0xffff0000u));
            *(GAS v4u*)(u2row + k) = uh;
            const bf16x8 ah = __builtin_bit_cast(bf16x8, uh), al = __builtin_bit_cast(bf16x8, ul);
            const bf16x8 bh0 = *(const GAS bf16x8*)(wh + k), bh1 = *(const GAS bf16x8*)(wh + 16 * D + k), bh2 = *(const GAS bf16x8*)(wh + 32 * D + k);
            acc0 = __builtin_amdgcn_mfma_f32_16x16x32_bf16(ah, bh0, acc0, 0, 0, 0); acc0 = __builtin_amdgcn_mfma_f32_16x16x32_bf16(al, bh0, acc0, 0, 0, 0);
            acc1 = __builtin_amdgcn_mfma_f32_16x16x32_bf16(ah, bh1, acc1, 0, 0, 0); acc1 = __builtin_amdgcn_mfma_f32_16x16x32_bf16(al, bh1, acc1, 0, 0, 0);
            acc2 = __builtin_amdgcn_mfma_f32_16x16x32_bf16(ah, bh2, acc2, 0, 0, 0); acc2 = __builtin_amdgcn_mfma_f32_16x16x32_bf16(al, bh2, acc2, 0, 0, 0);
        }
#pragma unroll
        for (int i = 0; i < 4; ++i) { LG[(4 * kg + i) * 49 + r] = acc0[i]; LG[(4 * kg + i) * 49 + 16 + r] = acc1[i]; LG[(4 * kg + i) * 49 + 32 + r] = acc2[i]; }
        LDS_WAIT();
        if (lane < 16) {
            float lg[36];
#pragma unroll
            for (int n = 0; n < 36; ++n) lg[n] = LG[lane * 49 + n] + (n < 4 ? bgrp[n] : brt[n - 4]);
            int grp = 0; float gm = lg[0];
#pragma unroll
            for (int i = 1; i < 4; ++i) if (lg[i] > gm) { gm = lg[i]; grp = i; }
            float se = 0.f;
#pragma unroll
            for (int i = 0; i < 4; ++i) se += __expf(lg[i] - gm);
            const float pg = 1.f / se;
            float ev[8];
#pragma unroll
            for (int i = 0; i < 8; ++i) ev[i] = grp == 0 ? lg[4 + i] : (grp == 1 ? lg[12 + i] : (grp == 2 ? lg[20 + i] : lg[28 + i]));
            int i1 = 0; float v1 = ev[0];
#pragma unroll
            for (int i = 1; i < 8; ++i) if (ev[i] > v1) { v1 = ev[i]; i1 = i; }
            int i2 = -1; float v2 = -3.0e38f;
#pragma unroll
            for (int i = 0; i < 8; ++i) if (i != i1 && ev[i] > v2) { v2 = ev[i]; i2 = i; }
            const float e2 = __expf(v2 - v1), g1 = pg / (1.f + e2), g2 = pg * e2 / (1.f + e2);
            const int ea = grp * 8 + i1, eb = grp * 8 + i2, rw = row0 + lane;
            tok_e[rw * 2] = ea; tok_e[rw * 2 + 1] = eb; tok_g[rw * 2] = g1; tok_g[rw * 2 + 1] = g2;
            const int ra = (int)__hip_atomic_fetch_add(&hist[ea], 1u, __ATOMIC_RELAXED, __HIP_MEMORY_SCOPE_WORKGROUP), rb = (int)__hip_atomic_fetch_add(&hist[eb], 1u, __ATOMIC_RELAXED, __HIP_MEMORY_SCOPE_WORKGROUP);
            LAS int* pe = pend + (wave * 16 + lane) * 4; pe[0] = ea; pe[1] = eb; pe[2] = ra; pe[3] = rb;
        }
        __syncthreads();
        if (tid < 32) { const unsigned n = hist[tid]; hist[32 + tid] = n ? atomicAdd(cnt + tid * 64, n) : 0u; }
        __syncthreads();
        if (tid < 128) { const LAS int* pe = pend + tid * 4; const int rw = tile * 128 + tid; const int ra = (int)hist[32 + pe[0]] + pe[2], rb = (int)hist[32 + pe[1]] + pe[3];
            tok_rank[rw * 2] = ra; tok_rank[rw * 2 + 1] = rb; inv[pe[0] * 65536 + ra] = rw; inv[pe[1] * 65536 + rb] = rw; }
        __syncthreads();
    }
}

__device__ __forceinline__ void moe_tables(Frame& F, const Args& a, const int l, const bool tiles, const bool gather) {
    unsigned char* ws = a.ws; const unsigned* cnt = (const unsigned*)(ws + WS_CTL) + CW_CNT + l * 32 * 64;
    LAS int* ttl = (LAS int*)(F.lds + TT_LDS_OFF); LAS int* pstart = ttl + 320; LAS int* pcnt = ttl + 360;
    const int tid = opaque_i(F.tid);
    __syncthreads();
    if (tid < 64) {
        const int e = tid & 31; const int c = (int)__hip_atomic_load(cnt + e * 64, RLX_AGENT); const int pad = (c + 255) / 256 * 256;
        int run = pad;
#pragma unroll
        for (int o = 1; o < 32; o <<= 1) { const int t = __shfl_up(run, o, 32); if (e >= o) run += t; }
        const int ps = run - pad;
        if (tid < 32) { pcnt[e] = c; pstart[e] = ps; if (e == 31) { pstart[32] = run; ttl[511] = run >> 8; }
            if (tiles) { for (int t = ps >> 8; t < (run >> 8); ++t) ttl[t] = e; } }
    }
    __syncthreads();
    if (gather) {
        LAS unsigned* goff = (LAS unsigned*)(F.lds + GOFF_LDS_OFF); const int* inv = (const int*)(ws + WS_INV);
        const int nu = ttl[511] * 4;
#pragma unroll
        for (int it = 0; it < MOE_UMAX * 256 / (NWAVES * 64); ++it) { const int s = tid + it * NWAVES * 64; const int i = s >> 8, r = s & 255, L = i * F.G + F.vcu; unsigned off = (unsigned)WS_ZROW;
            if (L < nu) { const int pm = L >> 2, e = ttl[pm], rank = pm * 256 - pstart[e] + r; if (rank < pcnt[e]) off = (unsigned)WS_U2 + (unsigned)inv[e * 65536 + rank] * 2048u; }
            goff[s] = off; }
        __syncthreads();
    }
}

__device__ __forceinline__ void phase_comb(Frame& F, const Args& a, const int l) {
    unsigned char* ws = a.ws;
    const float* mod = (const float*)(ws + WS_MOD); const bf16_t* Y = (const bf16_t*)(ws + WS_XS); bf16_t* Unext = (bf16_t*)(ws + WS_U); const bf16_t* X1 = (const bf16_t*)(ws + WS_Y);
    const int* tok_e = (const int*)(ws + WS_ROUTE + RT_TOKE); const int* tok_rank = (const int*)(ws + WS_ROUTE + RT_RANK); const float* tok_g = (const float*)(ws + WS_ROUTE + RT_TOKG);
    moe_tables(F, a, l, false, false); const LAS int* pstart = (const LAS int*)(F.lds + TT_LDS_OFF) + 320;
    const float* lng = a.in[4] + l * D; const float* lnb = a.in[5] + l * D; const float* lng1 = a.in[2] + l * D; const float* lnb1 = a.in[3] + l * D;
    const int lane = opaque_i(F.lane);
    const int gw = F.vcu * NWAVES + F.wave, NGW = F.G * NWAVES;
    for (int blk = gw; blk < T / 16; blk += NGW) {
        const int row0 = blk * 16, b = row0 / SEQ;
        const float* m = mod + (size_t)(l * 4 + b) * 6 * D; const float* mn = mod + (size_t)((l + 1) * 4 + b) * 6 * D;
        const int myslot = pstart[tok_e[row0 * 2 + (lane & 31)]] + tok_rank[row0 * 2 + (lane & 31)]; const float mygate = tok_g[row0 * 2 + (lane & 31)];
        f32x4 kg2[4], kln[4], klb[4], ksc[4], ksh[4], kl1[4], kb1[4];
#pragma unroll
        for (int j = 0; j < 4; ++j) { const int c = 4 * lane + 256 * j; kg2[j] = *(const f32x4*)(m + 5 * D + c) + 1.0f; kln[j] = *(const f32x4*)(lng + c); klb[j] = *(const f32x4*)(lnb + c); kl1[j] = *(const f32x4*)(lng1 + c); kb1[j] = *(const f32x4*)(lnb1 + c);
            if (l == 0) { ksc[j] = *(const f32x4*)(mn + 1 * D + c) + 1.0f; ksh[j] = *(const f32x4*)(mn + 0 * D + c); } else { ksc[j] = kg2[j]; ksh[j] = kg2[j]; } }
        v2u nx[4], np[4], nq[4];
#define COMB_LOAD(i_) do { const int sa_ = __shfl(myslot, 2 * (i_)), sb_ = __shfl(myslot, 2 * (i_) + 1); \
            const GAS v2u* xr_ = (const GAS v2u*)(X1 + (size_t)(row0 + (i_)) * D) + lane; const GAS v2u* ya_ = (const GAS v2u*)(Y + (size_t)sa_ * D) + lane; const GAS v2u* yb_ = (const GAS v2u*)(Y + (size_t)sb_ * D) + lane; \
            _Pragma("unroll") for (int j = 0; j < 4; ++j) { nx[j] = xr_[64 * j]; np[j] = ya_[64 * j]; nq[j] = yb_[64 * j]; } } while (0)
        COMB_LOAD(0);
        for (int i = 0; i < 16; ++i) {
            v2u cx[4], cp[4], cq[4];
#pragma unroll
            for (int j = 0; j < 4; ++j) { cx[j] = nx[j]; cp[j] = np[j]; cq[j] = nq[j]; }
            const float ga = __shfl(mygate, 2 * i), gb = __shfl(mygate, 2 * i + 1);
            if (i < 15) COMB_LOAD(i + 1);
            const int row = row0 + i;
            f32x4 v[4]; float s = 0.f;
            float ys = 0.f, yq = 0.f;
#pragma unroll
            for (int j = 0; j < 4; ++j) { const v2u xw = cx[j]; const float y0 = __uint_as_float(xw.x << 16), y1 = __uint_as_float(xw.x & 0xffff0000u), y2 = __uint_as_float(xw.y << 16), y3 = __uint_as_float(xw.y & 0xffff0000u);
                ys += (y0 + y1) + (y2 + y3); yq += (y0 * y0 + y1 * y1) + (y2 * y2 + y3 * y3); }
            const float mean1 = wave_sum(ys) * (1.f / D), rstd1 = rsqrtf(fmaxf(wave_sum(yq) * (1.f / D) - mean1 * mean1, 0.f) + LN_EPS);
#pragma unroll
            for (int j = 0; j < 4; ++j) {
                const v2u xw = cx[j], p = cp[j], q = cq[j]; const f32x4 g2 = kg2[j];
                const f32x4 yv = {__uint_as_float(xw.x << 16), __uint_as_float(xw.x & 0xffff0000u), __uint_as_float(xw.y << 16), __uint_as_float(xw.y & 0xffff0000u)};
                const f32x4 x1 = (yv - mean1) * rstd1 * kl1[j] + kb1[j];
                f32x4 f;
                f.x = ga * __uint_as_float(p.x << 16) + gb * __uint_as_float(q.x << 16); f.y = ga * __uint_as_float(p.x & 0xffff0000u) + gb * __uint_as_float(q.x & 0xffff0000u);
                f.z = ga * __uint_as_float(p.y << 16) + gb * __uint_as_float(q.y << 16); f.w = ga * __uint_as_float(p.y & 0xffff0000u) + gb * __uint_as_float(q.y & 0xffff0000u);
                v[j] = x1 * ALPHA + g2 * f;
                s += (v[j].x + v[j].y) + (v[j].z + v[j].w);
            }
            const float mean = wave_sum(s) * (1.f / D); float s2 = 0.f;
#pragma unroll
            for (int j = 0; j < 4; ++j) { v[j] = v[j] - mean; s2 += (v[j].x * v[j].x + v[j].y * v[j].y) + (v[j].z * v[j].z + v[j].w * v[j].w); }
            const float rstd = rsqrtf(wave_sum(s2) * (1.f / D) + LN_EPS);
#pragma unroll
            for (int j = 0; j < 4; ++j) {
                const f32x4 x2 = v[j] * rstd * kln[j] + klb[j];
                if (l == 0) {
                    const f32x4 u = x2 * ksc[j] + ksh[j];
                    v2u xw; xw.x = cvtpk_c(x2.x, x2.y); xw.y = cvtpk_c(x2.z, x2.w); ((GAS v2u*)((bf16_t*)a.out + (size_t)row * D))[lane + 64 * j] = xw;
                    v2u uw; uw.x = cvtpk_c(u.x, u.y); uw.y = cvtpk_c(u.z, u.w); ((GAS v2u*)(Unext + (size_t)row * D))[lane + 64 * j] = uw;
                } else ((GAS f32x4*)(a.out + (size_t)row * D))[lane + 64 * j] = x2;
            }
        }
#undef COMB_LOAD
    }
}

typedef short v4i16_t __attribute__((ext_vector_type(4)));
__device__ __forceinline__ int crow(int r, int hi) { return (r & 3) + 8 * (r >> 2) + 4 * hi; }
__device__ __forceinline__ unsigned cvtpk(float lo, float hi) { unsigned r; asm("v_cvt_pk_bf16_f32 %0, %1, %2" : "=v"(r) : "v"(lo), "v"(hi)); return r; }
#define MFMA32(a, b, c) __builtin_amdgcn_mfma_f32_32x32x16_bf16((a), (b), (c), 0, 0, 0)
constexpr int KCH = 1040;

template <int NCH> __device__ __forceinline__ void ktile_load(v4u (&reg)[NCH / 8], const bf16_t* gsrc, int pitch, int tid) {
#pragma unroll
    for (int i = 0; i < NCH / 8; ++i) { const int item = tid + 512 * i, row = item / NCH, c = item % NCH; reg[i] = *(const GAS v4u*)(gsrc + (size_t)row * pitch + c * 8); }
}
template <int NCH> __device__ __forceinline__ void ktile_store(const v4u (&reg)[NCH / 8], LAS unsigned char* dst, int tid) {
#pragma unroll
    for (int i = 0; i < NCH / 8; ++i) { const int item = tid + 512 * i, row = item / NCH, c = item % NCH; *(LAS v4u*)(dst + c * KCH + row * 16) = reg[i]; }
}
__device__ __forceinline__ bf16x8 kfrag(const LAS unsigned char* tile, int blk, int step, int r32, int hi) {
    return *(const LAS bf16x8*)(tile + (step * 2 + hi) * KCH + (blk * 32 + r32) * 16);
}
template <int NDB> __device__ __forceinline__ void vtile_load(v4u (&reg)[NDB / 2], const bf16_t* gsrc, int pitch, int tid) {
#pragma unroll
    for (int i = 0; i < NDB / 2; ++i) { const int item = tid + 512 * i, row = item / (NDB * 4), c = item % (NDB * 4); reg[i] = *(const GAS v4u*)(gsrc + (size_t)row * pitch + c * 8); }
}
template <int NDB> __device__ __forceinline__ void vtile_store(const v4u (&reg)[NDB / 2], LAS unsigned char* dst, int tid) {
#pragma unroll
    for (int i = 0; i < NDB / 2; ++i) { const int item = tid + 512 * i, row = item / (NDB * 4), c = item % (NDB * 4);
        *(LAS v4u*)(dst + ((c >> 2) * 4 + (row >> 4)) * 1024 + (row & 15) * 64 + (c & 3) * 16) = reg[i]; }
}
__device__ __forceinline__ int vfrag_lane_off(int lane) { return ((lane >> 4) & 1) * 32 + (lane & 3) * 8 + (4 * (lane >> 5) + ((lane & 15) >> 2)) * 64; }
__device__ __forceinline__ bf16x8 vfrag(const LAS unsigned char* tile, int db, int s, int laneoff) {
    const LAS unsigned char* p = tile + (db * 4 + s) * 1024 + laneoff;
    const s16x4 lo = __builtin_bit_cast(s16x4, __builtin_amdgcn_ds_read_tr16_b64_v4i16((LAS v4i16_t*)p));
    const s16x4 hi = __builtin_bit_cast(s16x4, __builtin_amdgcn_ds_read_tr16_b64_v4i16((LAS v4i16_t*)(p + 512)));
    return (bf16x8){lo[0], lo[1], lo[2], lo[3], hi[0], hi[1], hi[2], hi[3]};
}
__device__ __forceinline__ int vfragn_lane_off(int lane) { return ((lane >> 4) & 1) * 32 + (lane & 3) * 8 + (8 * (lane >> 5) + ((lane & 15) >> 2)) * 64; }
__device__ __forceinline__ bf16x8 vfragn(const LAS unsigned char* tile, int db, int s, int laneoff) {
    const LAS unsigned char* p = tile + (db * 4 + s) * 1024 + laneoff;
    const s16x4 lo = __builtin_bit_cast(s16x4, __builtin_amdgcn_ds_read_tr16_b64_v4i16((LAS v4i16_t*)p));
    const s16x4 hi = __builtin_bit_cast(s16x4, __builtin_amdgcn_ds_read_tr16_b64_v4i16((LAS v4i16_t*)(p + 256)));
    return (bf16x8){lo[0], lo[1], lo[2], lo[3], hi[0], hi[1], hi[2], hi[3]};
}
__device__ __forceinline__ bf16x8 pfrag(const f32x16& p, int s) {
    v4u w; w.x = cvtpk(p[8 * s + 0], p[8 * s + 1]); w.y = cvtpk(p[8 * s + 2], p[8 * s + 3]); w.z = cvtpk(p[8 * s + 4], p[8 * s + 5]); w.w = cvtpk(p[8 * s + 6], p[8 * s + 7]);
    return __builtin_bit_cast(bf16x8, w);
}

__device__ __forceinline__ void sbdma16(const void* gsrc, LAS unsigned char* dst) { unsigned keep; const unsigned d = (unsigned)__builtin_amdgcn_readfirstlane((int)(unsigned)(uintptr_t)dst);
    asm volatile("s_mov_b32 %0, m0\n\ts_mov_b32 m0, %2\n\ts_nop 0\n\tglobal_load_lds_dwordx4 %1, off\n\ts_mov_b32 m0, %0" : "=&s"(keep) : "v"(gsrc), "s"(d) : "memory"); }
constexpr int S2_K = 0, S2_V = 24576, S2_FLAG = 49152;
template <bool MASKED> __device__ __forceinline__ void sb_scores(f32x16 (&p)[2], float& carry, int kbase, int trow, int hi) {
    float lb[2][16];
#pragma unroll
    for (int blk = 0; blk < 2; ++blk)
#pragma unroll
        for (int r = 0; r < 16; ++r) {
            const float z = p[blk][r]; const bool valid = !MASKED || (kbase + 32 * blk + crow(r, hi)) < trow;
            const float sp = fmaxf(z, 0.f) + __builtin_amdgcn_logf(1.f + __builtin_amdgcn_exp2f(-fabsf(z)));
            lb[blk][r] = valid ? -sp : 0.f; p[blk][r] = valid ? (z - sp) : -1.0e30f;
        }
    float own[8], oth[8];
#pragma unroll
    for (int i = 0; i < 8; ++i) { const int blk = i >> 2, g = i & 3; own[i] = (lb[blk][4 * g] + lb[blk][4 * g + 1]) + (lb[blk][4 * g + 2] + lb[blk][4 * g + 3]); oth[i] = __shfl_xor(own[i], 32); }
    float suf[8]; float run = 0.f;
#pragma unroll
    for (int i = 7; i >= 0; --i) { suf[i] = run; run += own[i] + oth[i]; }
#pragma unroll
    for (int i = 0; i < 8; ++i) {
        const int blk = i >> 2, g = i & 3;
        const float off = carry + suf[i] + (hi == 0 ? oth[i] : 0.f);
        const float b3 = off, b2 = b3 + lb[blk][4 * g + 3], b1 = b2 + lb[blk][4 * g + 2], b0 = b1 + lb[blk][4 * g + 1];
        p[blk][4 * g + 0] = __builtin_amdgcn_exp2f(p[blk][4 * g + 0] + b0); p[blk][4 * g + 1] = __builtin_amdgcn_exp2f(p[blk][4 * g + 1] + b1);
        p[blk][4 * g + 2] = __builtin_amdgcn_exp2f(p[blk][4 * g + 2] + b2); p[blk][4 * g + 3] = __builtin_amdgcn_exp2f(p[blk][4 * g + 3] + b3);
    }
    carry += run;
}
constexpr float SB_CUT = -32.f;
__device__ __forceinline__ void sb_unit2(Frame& F, const bf16_t* proj, bf16_t* mix, int b, int h, int qb) {
    const int tid = opaque_i(F.tid), lane = tid & 63, r32 = lane & 31, hi = lane >> 5, wave = F.wave;
    LAS unsigned char* lds = F.lds + RING_OFF;
    LAS unsigned* flags = (LAS unsigned*)(lds + S2_FLAG);
    const bf16_t* base = proj + (size_t)b * SEQ * EVEN_IN;
    const int q0 = qb * 256, trow = q0 + 32 * wave + r32, mydiag = (q0 + 32 * wave) >> 6, jmax = (q0 >> 6) + 3;
    bf16x8 qr[4];
#pragma unroll
    for (int s = 0; s < 4; ++s) qr[s] = *(const GAS bf16x8*)(base + (size_t)trow * EVEN_IN + P0_SQ + h * 64 + s * 16 + hi * 8);
#pragma unroll
    for (int s = 0; s < 4; ++s) asm volatile("" : "+v"(qr[s]));
    if (tid < 8) flags[tid] = 0u;
    const int krow = 8 * wave + (lane >> 3), kch = (lane & 7) ^ ((krow >> 1) & 7);
    const bf16_t* kg0 = base + (size_t)krow * EVEN_IN + P0_SK + h * 64 + kch * 8;
    const bf16_t* vg0 = base + (size_t)((wave & 3) * 16 + (lane >> 2)) * EVEN_IN + P0_SV + h * 64 + (wave >> 2) * 32 + (lane & 3) * 8;
#define S2_DMA(t, bi) do { const size_t to_ = (size_t)(t) * 64 * EVEN_IN; sbdma16(kg0 + to_, lds + S2_K + (bi) * 8192 + wave * 1024); sbdma16(vg0 + to_, lds + S2_V + (bi) * 8192 + wave * 1024); } while (0)
    const int kswz = (r32 >> 1) & 7, krd = r32 * 128;
#define S2_KFRAG(kt, blk, s) (*(const LAS bf16x8*)((kt) + krd + (blk) * 4096 + ((((s) * 2 + hi) ^ kswz) << 4)))
    const int voff = vfrag_lane_off(lane);
    __syncthreads();
    int bj = jmax % 3;
    S2_DMA(jmax, bj); { const int b1_ = bj == 0 ? 2 : bj - 1; S2_DMA(jmax - 1, b1_); }
    f32x16 o0 = {}, o1 = {};
    float carry = 0.f;
    asm volatile("s_waitcnt vmcnt(2) lgkmcnt(0)" ::: "memory");
    __builtin_amdgcn_s_barrier();
    bool mydone = false, alldone = false;
#define S2_DMA_STEP(j_) do { if ((j_) >= 2) { const int b2_ = bj == 2 ? 0 : bj + 1; S2_DMA((j_) - 2, b2_); } } while (0)
#define S2_END_STEP(done_) do { if (lane == 0) flags[wave] = (done_) ? 1u : 0u; \
        if (j >= 2) asm volatile("s_waitcnt vmcnt(2) lgkmcnt(0)" ::: "memory"); else asm volatile("s_waitcnt vmcnt(0) lgkmcnt(0)" ::: "memory"); \
        __builtin_amdgcn_s_barrier(); asm volatile("" ::: "memory"); bj = bj == 0 ? 2 : bj - 1; unsigned f_ = 1u; _Pragma("unroll") for (int w_ = 0; w_ < 8; ++w_) f_ &= flags[w_]; alldone = f_ != 0u; } while (0)
#define S2_QK(kt_) do { p[0] = (f32x16){}; p[1] = (f32x16){}; _Pragma("unroll") for (int s_ = 0; s_ < 4; ++s_) { p[0] = MFMA32(S2_KFRAG((kt_), 0, s_), qr[s_], p[0]); p[1] = MFMA32(S2_KFRAG((kt_), 1, s_), qr[s_], p[1]); } } while (0)
#define S2_PV(vt_) do { _Pragma("unroll") for (int s_ = 0; s_ < 4; ++s_) { const bf16x8 pf_ = pfrag(p[s_ >> 1], s_ & 1); o0 = MFMA32(vfrag((vt_), 0, s_, voff), pf_, o0); o1 = MFMA32(vfrag((vt_), 1, s_, voff), pf_, o1); } } while (0)
    int j = jmax;
    while (j > mydiag) { S2_DMA_STEP(j); S2_END_STEP(false); --j; }
    {
        S2_DMA_STEP(j);
        const LAS unsigned char* kt = lds + S2_K + bj * 8192; const LAS unsigned char* vt = lds + S2_V + bj * 8192;
        f32x16 p[2]; S2_QK(kt);
        sb_scores<true>(p, carry, j * 64, trow, hi);
        S2_PV(vt);
        mydone = __all(carry < SB_CUT);
        S2_END_STEP(mydone); --j;
    }
    while (j >= 0 && !alldone && !mydone) {
        S2_DMA_STEP(j);
        const LAS unsigned char* kt = lds + S2_K + bj * 8192; const LAS unsigned char* vt = lds + S2_V + bj * 8192;
        f32x16 p[2]; S2_QK(kt);
        sb_scores<false>(p, carry, j * 64, trow, hi);
        S2_PV(vt);
        mydone = __all(carry < SB_CUT);
        S2_END_STEP(mydone); --j;
    }
    while (j >= 0 && !alldone) { S2_DMA_STEP(j); S2_END_STEP(true); --j; }
#undef S2_DMA
#undef S2_KFRAG
#undef S2_DMA_STEP
#undef S2_END_STEP
#undef S2_QK
#undef S2_PV
    asm volatile("s_waitcnt vmcnt(0) lgkmcnt(0)" ::: "memory");
    bf16_t* op = mix + ((size_t)b * SEQ + trow) * D + h * 64;
#pragma unroll
    for (int g = 0; g < 4; ++g) {
        v2u w0; w0.x = cvtpk(o0[4 * g], o0[4 * g + 1]); w0.y = cvtpk(o0[4 * g + 2], o0[4 * g + 3]);
        v2u w1; w1.x = cvtpk(o1[4 * g], o1[4 * g + 1]); w1.y = cvtpk(o1[4 * g + 2], o1[4 * g + 3]);
        *(GAS v2u*)(op + 8 * g + 4 * hi) = w0; *(GAS v2u*)(op + 32 + 8 * g + 4 * hi) = w1;
    }
    __syncthreads();
}

__device__ __forceinline__ float ret_log2gamma(int h) { return __builtin_amdgcn_logf(1.f - __builtin_amdgcn_exp2f(-5.f - (float)h)); }
__device__ __forceinline__ void ret_kv_phase(Frame& F, const bf16_t* proj, bf16_t* state, bf16_t* tot) {
    const int tid = opaque_i(F.tid), lane = tid & 63, r32 = lane & 31, hi = lane >> 5, wave = F.wave;
    LAS unsigned char* lds = F.lds + RING_OFF;
    LAS unsigned char* oimg = lds + 32768;
    const int eb = wave >> 1, voffn = vfragn_lane_off(lane);
    v4u kreg[2], vreg[2];
    for (int gu = F.vcu; gu < 256; gu += F.G) {
        const int bh = gu >> 4, grp = gu & 15, h = bh & 3;
        const float lg2 = ret_log2gamma(h), dec64 = __builtin_amdgcn_exp2f(lg2 * 64.f);
        { const bf16_t* base = proj + ((size_t)(bh >> 2) * SEQ + (grp * 8) * 64) * EVEN_IN;
          vtile_load<4>(kreg, base + P0_RK + h * 128, EVEN_IN, tid); vtile_load<4>(vreg, base + P0_RV + h * 128, EVEN_IN, tid); }
        f32x16 acc[2]; acc[0] = (f32x16){}; acc[1] = (f32x16){};
        for (int j = 0; j <= 8; ++j) {
            const int n = grp * 8 + j;
            if (j < 8) {
#pragma unroll
                for (int i = 0; i < 2; ++i) { const int item = tid + 512 * i, row = item / 16; const float dec = __builtin_amdgcn_exp2f(lg2 * (float)(63 - row));
                    v4u k = kreg[i];
                    k.x = cvtpk_c(__uint_as_float(k.x << 16) * dec, __uint_as_float(k.x & 0xffff0000u) * dec); k.y = cvtpk_c(__uint_as_float(k.y << 16) * dec, __uint_as_float(k.y & 0xffff0000u) * dec);
                    k.z = cvtpk_c(__uint_as_float(k.z << 16) * dec, __uint_as_float(k.z & 0xffff0000u) * dec); k.w = cvtpk_c(__uint_as_float(k.w << 16) * dec, __uint_as_float(k.w & 0xffff0000u) * dec);
                    kreg[i] = k; }
                vtile_store<4>(kreg, lds, tid); vtile_store<4>(vreg, lds + 16384, tid);
                if (j < 7) { const bf16_t* base2 = proj + ((size_t)(bh >> 2) * SEQ + (n + 1) * 64) * EVEN_IN;
                    vtile_load<4>(kreg, base2 + P0_RK + h * 128, EVEN_IN, tid); vtile_load<4>(vreg, base2 + P0_RV + h * 128, EVEN_IN, tid); }
            }
#pragma unroll
            for (int i = 0; i < 2; ++i)
#pragma unroll
                for (int r = 0; r < 16; ++r) *(LAS bf16_t*)(oimg + (eb * 32 + crow(r, hi)) * 272 + ((2 * (wave & 1) + i) * 32 + r32) * 2) = (bf16_t)f2bf(acc[i][r]);
            __syncthreads();
            bf16_t* st = (j < 8) ? state + ((size_t)bh * 128 + n) * 16384 : tot + ((size_t)bh * 16 + grp) * 16384;
#pragma unroll
            for (int i = 0; i < 4; ++i) { const int item = tid + 512 * i, e = item >> 4, c = item & 15; *(GAS v4u*)(st + (size_t)e * 128 + c * 8) = *(const LAS v4u*)(oimg + e * 272 + c * 16); }
            if (j < 8) {
#pragma unroll
                for (int i = 0; i < 2; ++i)
#pragma unroll
                    for (int r = 0; r < 16; ++r) acc[i][r] *= dec64;
#pragma unroll
                for (int s = 0; s < 4; ++s) { const bf16x8 af = vfragn(lds + 16384, eb, s, voffn);
#pragma unroll
                    for (int i = 0; i < 2; ++i) acc[i] = MFMA32(af, vfragn(lds, 2 * (wave & 1) + i, s, voffn), acc[i]); }
            }
            __syncthreads();
        }
    }
}
__device__ __forceinline__ void ret_scan(Frame& F, const bf16_t* tot, bf16_t* gst) {
    const int gt = F.vcu * NWAVES * 64 + opaque_i(F.tid);
    for (int p = gt; p < 16 * 8192; p += F.G * NWAVES * 64) {
        const int bh = p >> 13, pr = p & 8191; const float dec = __builtin_amdgcn_exp2f(ret_log2gamma(bh & 3) * 512.f);
        const GAS unsigned* ptr = (const GAS unsigned*)(tot + (size_t)bh * 16 * 16384) + pr; GAS unsigned* optr = (GAS unsigned*)(gst + (size_t)bh * 16 * 16384) + pr;
        float s0 = 0.f, s1 = 0.f;
#pragma unroll
        for (int g = 0; g < 16; ++g) { const unsigned kv = ptr[(size_t)g * 8192]; optr[(size_t)g * 8192] = cvtpk_c(s0, s1);
            s0 = dec * s0 + __uint_as_float(kv << 16); s1 = dec * s1 + __uint_as_float(kv & 0xffff0000u); }
    }
}
constexpr int RO_LDS_K = 0, RO_LDS_V = 16 * KCH, RO_LDS_ST = RO_LDS_V + 16384;
__device__ __forceinline__ void ret_out_phase(Frame& F, const bf16_t* proj, const bf16_t* state, const bf16_t* gst, const float* gn, bf16_t* mix) {
    const int tid = opaque_i(F.tid), lane = tid & 63, r32 = lane & 31, hi = lane >> 5, wave = F.wave;
    LAS unsigned char* lds = F.lds + RING_OFF;
    v4u kreg[2], vreg[2];
    int u = F.vcu;
    if (u < 2048) { const int bh0 = u >> 7, n0 = u & 127; const bf16_t* base0 = proj + ((size_t)(bh0 >> 2) * SEQ + n0 * 64) * EVEN_IN;
        ktile_load<16>(kreg, base0 + P0_RK + (bh0 & 3) * 128, EVEN_IN, tid); vtile_load<4>(vreg, base0 + P0_RV + (bh0 & 3) * 128, EVEN_IN, tid); }
    for (; u < 2048; u += F.G) {
    const int bh = u >> 7, n = u & 127, b = bh >> 2, h = bh & 3;
    const bf16_t* base = proj + ((size_t)b * SEQ + n * 64) * EVEN_IN;
    const float lg2 = ret_log2gamma(h);
    const int eb = wave >> 1, cb = wave & 1, c = cb * 32 + r32;
    bf16x8 qf[8];
#pragma unroll
    for (int s = 0; s < 8; ++s) qf[s] = *(const GAS bf16x8*)(base + (size_t)c * EVEN_IN + P0_RQ + h * 128 + s * 16 + hi * 8);
    ktile_store<16>(kreg, lds + RO_LDS_K, tid); vtile_store<4>(vreg, lds + RO_LDS_V, tid);
    const bf16_t* st = state + ((size_t)bh * 128 + n) * 16384 + (size_t)(eb * 32 + r32) * 128;
    const bf16_t* sg = gst + ((size_t)bh * 16 + (n >> 3)) * 16384 + (size_t)(eb * 32 + r32) * 128;
    f32x16 oj = {}, og = {};
#pragma unroll
    for (int s = 0; s < 8; ++s) og = MFMA32(*(const GAS bf16x8*)(sg + s * 16 + hi * 8), qf[s], og);
    __builtin_amdgcn_sched_barrier(0);
#pragma unroll
    for (int s = 0; s < 8; ++s) oj = MFMA32(*(const GAS bf16x8*)(st + s * 16 + hi * 8), qf[s], oj);
    { const float gd = __builtin_amdgcn_exp2f(lg2 * (float)(64 * (n & 7)));
#pragma unroll
      for (int r = 0; r < 16; ++r) oj[r] += gd * og[r]; }
    __builtin_amdgcn_sched_barrier(0);
    { const int un = u + F.G; if (un < 2048) { const int bh2 = un >> 7, n2 = un & 127; const bf16_t* base2 = proj + ((size_t)(bh2 >> 2) * SEQ + n2 * 64) * EVEN_IN;
        ktile_load<16>(kreg, base2 + P0_RK + (bh2 & 3) * 128, EVEN_IN, tid); vtile_load<4>(vreg, base2 + P0_RV + (bh2 & 3) * 128, EVEN_IN, tid); } }
    __syncthreads();
    f32x16 p[2]; p[0] = (f32x16){}; p[1] = (f32x16){};
#pragma unroll
    for (int s = 0; s < 8; ++s) { p[0] = MFMA32(kfrag(lds + RO_LDS_K, 0, s, r32, hi), qf[s], p[0]); p[1] = MFMA32(kfrag(lds + RO_LDS_K, 1, s, r32, hi), qf[s], p[1]); }
#pragma unroll
    for (int blk = 0; blk < 2; ++blk)
#pragma unroll
        for (int r = 0; r < 16; ++r) p[blk][r] *= __builtin_amdgcn_exp2f(lg2 * fabsf((float)(c - (32 * blk + crow(r, hi)))));
    const int voff = vfrag_lane_off(lane);
    f32x16 o = {};
#pragma unroll
    for (int s = 0; s < 4; ++s) o = MFMA32(vfrag(lds + RO_LDS_V, eb, s, voff), pfrag(p[s >> 1], s & 1), o);
    const float qd = __builtin_amdgcn_exp2f(lg2 * (float)(c + 1));
    float s1 = 0.f, s2 = 0.f;
#pragma unroll
    for (int r = 0; r < 16; ++r) { o[r] += qd * oj[r]; s1 += o[r]; s2 += o[r] * o[r]; }
    s1 += __shfl_xor(s1, 32); s2 += __shfl_xor(s2, 32);
    typedef float f32x2v __attribute__((ext_vector_type(2)));
    LAS f32x2v* stt = (LAS f32x2v*)(lds + RO_LDS_ST);
    if (hi == 0) stt[eb * 64 + c] = (f32x2v){s1, s2};
    __syncthreads();
    float t1 = 0.f, t2 = 0.f;
#pragma unroll
    for (int i = 0; i < 4; ++i) { const f32x2v v = stt[i * 64 + c]; t1 += v.x; t2 += v.y; }
    const float mu = t1 * (1.f / 128.f), rstd = rsqrtf(fmaxf(t2 * (1.f / 128.f) - mu * mu, 0.f) + LN_EPS);
    const bf16_t* gp = base + (size_t)c * EVEN_IN + P0_RG + h * 128 + eb * 32;
    bf16_t* op = mix + ((size_t)b * SEQ + n * 64 + c) * D + 512 + h * 128 + eb * 32;
    const float* gnp = gn + h * 128 + eb * 32;
#pragma unroll
    for (int g = 0; g < 4; ++g) {
        const int e0 = 8 * g + 4 * hi; const v2u gg = *(const GAS v2u*)(gp + e0); const f32x4 gain = *(const f32x4*)(gnp + e0);
        const float g0 = __uint_as_float(gg.x << 16), g1 = __uint_as_float(gg.x & 0xffff0000u), g2 = __uint_as_float(gg.y << 16), g3 = __uint_as_float(gg.y & 0xffff0000u);
        v2u w; w.x = cvtpk((o[4 * g] - mu) * rstd * gain.x * silu_f(g0), (o[4 * g + 1] - mu) * rstd * gain.y * silu_f(g1));
        w.y = cvtpk((o[4 * g + 2] - mu) * rstd * gain.z * silu_f(g2), (o[4 * g + 3] - mu) * rstd * gain.w * silu_f(g3));
        *(GAS v2u*)(op + e0) = w;
    }
    __syncthreads();
    }
}

__device__ __forceinline__ void phase_mixa0(Frame& F, const Args& a) {
    const bf16_t* proj = (const bf16_t*)(a.ws + WS_BIG); bf16_t* mix = (bf16_t*)(a.ws + WS_MIX); bf16_t* state = (bf16_t*)(a.ws + WS_U);
    ret_kv_phase(F, proj, state, (bf16_t*)a.out);
#if defined(PROBE_MIXA) && PROBE_MIXA == 2
    for (int u = F.vcu; u < 1024; u += F.G) sb_unit2(F, proj, mix, u >> 8, (u >> 5) & 7, u & 31);
#endif
    for (int u = F.vcu; u < 1024; u += F.G) sb_unit2(F, proj, mix, u >> 8, (u >> 5) & 7, u & 31);
}
__device__ __forceinline__ void phase_scan0(Frame& F, const Args& a) { ret_scan(F, (const bf16_t*)a.out, (bf16_t*)a.out + 256 * 16384); }
__device__ __forceinline__ void phase_mixb0(Frame& F, const Args& a) {
    const bf16_t* proj = (const bf16_t*)(a.ws + WS_BIG); bf16_t* mix = (bf16_t*)(a.ws + WS_MIX); const bf16_t* state = (const bf16_t*)(a.ws + WS_U);
    ret_out_phase(F, proj, state, (const bf16_t*)a.out + 256 * 16384, a.in[10], mix);
}

constexpr float DF_THR = 64.f;
__device__ __forceinline__ void dma16(const void* gsrc, LAS unsigned char* dst) { unsigned keep; const unsigned d = (unsigned)__builtin_amdgcn_readfirstlane((int)(unsigned)(uintptr_t)dst);
    asm volatile("s_mov_b32 %0, m0\n\ts_mov_b32 m0, %2\n\ts_nop 0\n\tglobal_load_lds_dwordx4 %1, off\n\ts_mov_b32 m0, %0" : "=&s"(keep) : "v"(gsrc), "s"(d) : "memory"); }
constexpr int D3_K0 = 0, D3_K1 = 32768, D3_V = 65536;
constexpr int D3_KN = TT_LDS_OFF, D3_FLAG = TT_LDS_OFF + 1024, D3_Q = TT_LDS_OFF + 1088;
#ifndef PROBE_CUTX
#define PROBE_CUTX 0.f
#endif
template <int PVAR> __device__ __forceinline__ void diff_unit3(Frame& F, const bf16_t* proj, bf16_t* mix, const float* subg, const float* kn2, float lam, int b, int h, int qb) {
    const int tid = opaque_i(F.tid), lane = tid & 63, r32 = lane & 31, hi = lane >> 5, wave = F.wave, m = wave >> 2, wq = wave & 3;
    LAS unsigned char* lds = F.lds + RING_OFF;
    LAS float* KN = (LAS float*)(F.lds + D3_KN); LAS unsigned* flags = (LAS unsigned*)(F.lds + D3_FLAG);
    const bf16_t* base = proj + (size_t)b * SEQ * ODD_IN;
    const int q0 = qb * 128, trow = q0 + 32 * wq + r32, pmax = qb;
    const float slope2 = __builtin_amdgcn_exp2f(-(float)(h + 1)) * LOG2E;
    bf16x8 qr[4];
#pragma unroll
    for (int s = 0; s < 4; ++s) qr[s] = *(const GAS bf16x8*)(base + (size_t)trow * ODD_IN + P1_Q + h * 128 + m * 64 + s * 16 + hi * 8);
    float qn;
    { float t = 0.f;
#pragma unroll
      for (int s = 0; s < 4; ++s) { const v4u v = __builtin_bit_cast(v4u, qr[s]);
          t += __uint_as_float(v.x << 16) * __uint_as_float(v.x << 16) + __uint_as_float(v.x & 0xffff0000u) * __uint_as_float(v.x & 0xffff0000u);
          t += __uint_as_float(v.y << 16) * __uint_as_float(v.y << 16) + __uint_as_float(v.y & 0xffff0000u) * __uint_as_float(v.y & 0xffff0000u);
          t += __uint_as_float(v.z << 16) * __uint_as_float(v.z << 16) + __uint_as_float(v.z & 0xffff0000u) * __uint_as_float(v.z & 0xffff0000u);
          t += __uint_as_float(v.w << 16) * __uint_as_float(v.w << 16) + __uint_as_float(v.w & 0xffff0000u) * __uint_as_float(v.w & 0xffff0000u); }
      t += __shfl_xor(t, 32); qn = sqrtf(t) * 1.0001f; }
    if (wq == 0) {
        const f32x4 kv = *(const f32x4*)(kn2 + (((size_t)b * 16 + h * 2 + m) * 128 + 2 * lane) * 2);
        float v0 = kv.x + kv.y, v1 = kv.z + kv.w; v1 = fmaxf(v0, v1);
        float run = v1;
#pragma unroll
        for (int o = 1; o < 64; o <<= 1) { const float t = __shfl_up(run, o); if (lane >= o) run = fmaxf(run, t); }
        const float prev = __shfl_up(run, 1);
        KN[m * 128 + 2 * lane] = sqrtf(lane ? fmaxf(prev, v0) : v0); KN[m * 128 + 2 * lane + 1] = sqrtf(run);
    }
    if (tid < 8) flags[tid] = 0u;
    const int krow = 8 * wave + (lane >> 3), kch = (lane & 7) ^ ((krow >> 1) & 7);
    const bf16_t* kg0 = base + (size_t)krow * ODD_IN + P1_K + h * 128 + kch * 8;
    const int vs0 = 2 * wave, vs1 = 2 * wave + 1;
    const bf16_t* vg0 = base + (size_t)((vs0 & 3) * 16 + (lane >> 2)) * ODD_IN + P1_V + h * 128 + (vs0 >> 2) * 32 + (lane & 3) * 8;
    const bf16_t* vg1 = base + (size_t)((vs1 & 3) * 16 + (lane >> 2)) * ODD_IN + P1_V + h * 128 + (vs1 >> 2) * 32 + (lane & 3) * 8;
#define D3_DMA_T(t) do { if (PVAR == 4) break; const size_t to_ = (size_t)(t) * 64 * ODD_IN; const int sl_ = (t) & 3; LAS unsigned char* kb_ = lds + sl_ * 8192 + wave * 1024; LAS unsigned char* vb_ = lds + D3_V + sl_ * 16384; \
        dma16(kg0 + to_, kb_ + D3_K0); dma16(kg0 + to_ + 64, kb_ + D3_K1); dma16(vg0 + to_, vb_ + vs0 * 1024); dma16(vg1 + to_, vb_ + vs1 * 1024); } while (0)
#define D3_DMA_PAIR(p_) do { D3_DMA_T(2 * (p_) + 1); D3_DMA_T(2 * (p_)); } while (0)
    const int kswz = (r32 >> 1) & 7, krd = r32 * 128;
#define D3_KFRAG(kt, blk, s) (*(const LAS bf16x8*)((kt) + krd + (blk) * 4096 + ((((s) * 2 + hi) ^ kswz) << 4)))
    const int voff = vfrag_lane_off(lane);
    __syncthreads();
    D3_DMA_PAIR(pmax); if (pmax >= 1) D3_DMA_PAIR(pmax - 1);
    f32x16 o[4]; o[0] = (f32x16){}; o[1] = (f32x16){}; o[2] = (f32x16){}; o[3] = (f32x16){};
    float mref = -1.0e30f, l = 0.f, skl = 0.f;
    const float tgeo = -__builtin_amdgcn_logf(1.f - __builtin_amdgcn_exp2f(-64.f * slope2));
    if (pmax >= 1) asm volatile("s_waitcnt vmcnt(8) lgkmcnt(0)" ::: "memory"); else asm volatile("s_waitcnt vmcnt(0) lgkmcnt(0)" ::: "memory");
    __builtin_amdgcn_s_barrier();
    bool mydone = false, alldone = false;
    const float c4hi = slope2 * (float)(4 * hi), c32 = slope2 * 32.f;
    bf16x8 vf[2][4];
#define D3_VPRE(vt_) do { _Pragma("unroll") for (int db_ = 0; db_ < 4; ++db_) vf[0][db_] = vfrag((vt_), db_, 0, voff); __builtin_amdgcn_sched_barrier(0); } while (0)
#define D3_PV(vt_, SUB) do { float ls_ = 0.f; _Pragma("unroll") for (int s_ = 0; s_ < 4; ++s_) { \
            if (s_ < 3) { _Pragma("unroll") for (int db_ = 0; db_ < 4; ++db_) vf[(s_ + 1) & 1][db_] = vfrag((vt_), db_, s_ + 1, voff); } \
            f32x16& sc_ = (s_ >> 1) ? sc1 : sc0; \
            _Pragma("unroll") for (int r_ = 8 * (s_ & 1); r_ < 8 * (s_ & 1) + 8; ++r_) { sc_[r_] = __builtin_amdgcn_exp2f(sc_[r_] - (SUB)); ls_ += sc_[r_]; } \
            const bf16x8 pf_ = pfrag(sc_, s_ & 1); \
            _Pragma("unroll") for (int db_ = 0; db_ < 4; ++db_) o[db_] = MFMA32(vf[s_ & 1][db_], pf_, o[db_]); \
            __builtin_amdgcn_sched_barrier(0); } l += ls_; } while (0)
#define D3_DIAG(jt) do { const LAS unsigned char* kt = lds + (m ? D3_K1 : D3_K0) + ((jt) & 3) * 8192; const LAS unsigned char* vt = lds + D3_V + ((jt) & 3) * 16384; \
        f32x16 sc0 = {}, sc1 = {}; bf16x8 kf[4][2]; \
        _Pragma("unroll") for (int s = 0; s < 4; ++s) { kf[s][0] = D3_KFRAG(kt, 0, s); kf[s][1] = D3_KFRAG(kt, 1, s); } \
        __builtin_amdgcn_sched_barrier(0); \
        _Pragma("unroll") for (int s = 0; s < 4; ++s) { sc0 = MFMA32(kf[s][0], qr[s], sc0); sc1 = MFMA32(kf[s][1], qr[s], sc1); } \
        D3_VPRE(vt); \
        const float dq = (float)(trow - (jt) * 64); float mx = -1.0e30f; \
        _Pragma("unroll") for (int r = 0; r < 16; ++r) { sc0[r] -= slope2 * fabsf(dq - (float)crow(r, hi)); sc1[r] -= slope2 * fabsf(dq - (float)(32 + crow(r, hi))); mx = fmaxf(mx, fmaxf(sc0[r], sc1[r])); } \
        mx = fmaxf(mx, __shfl_xor(mx, 32)); mref = mx; l = 0.f; \
        D3_PV(vt, mx); } while (0)
#define D3_NORMAL(jt, knv) do { const float bnd = qn * (knv) - slope2 * (float)(trow - (64 * (jt) + 63)) - mref; \
        if (__all(bnd < -(PROBE_CUTX + 32.f + tgeo))) { mydone = true; break; } \
        if (PVAR == 9) break;          \
        const LAS unsigned char* kt = lds + (m ? D3_K1 : D3_K0) + ((jt) & 3) * 8192; const LAS unsigned char* vt = lds + D3_V + ((jt) & 3) * 16384; \
        f32x16 sc0, sc1; bf16x8 kf[4][2]; \
        _Pragma("unroll") for (int s = 0; s < 4; ++s) { kf[s][0] = D3_KFRAG(kt, 0, s); kf[s][1] = D3_KFRAG(kt, 1, s); } \
        __builtin_amdgcn_sched_barrier(0); \
        { const float loff = slope2 * (float)(64 * (jt) - trow) - mref + c4hi; \
          _Pragma("unroll") for (int r = 0; r < 16; ++r) { sc0[r] = fmaf(slope2, (float)((r & 3) + 8 * (r >> 2)), loff); sc1[r] = sc0[r] + c32; } } \
        _Pragma("unroll") for (int s = 0; s < 4; ++s) { sc0 = MFMA32(kf[s][0], qr[s], sc0); sc1 = MFMA32(kf[s][1], qr[s], sc1); } \
        if (__all(bnd < -20.f)) {         \
            float mq = -1.0e30f; _Pragma("unroll") for (int r = 0; r < 16; ++r) mq = fmaxf(mq, fmaxf(sc0[r], sc1[r])); \
            const float add = 32.f * __builtin_amdgcn_exp2f(mq); if (__all(skl + add <= 0x1p-27f)) { skl += add; break; } } \
        D3_VPRE(vt); \
        if (__any(bnd > DF_THR)) { float mx = -1.0e30f; \
            _Pragma("unroll") for (int r = 0; r < 16; ++r) mx = fmaxf(mx, fmaxf(sc0[r], sc1[r])); \
            mx = fmaxf(mx, __shfl_xor(mx, 32)); \
            if (__any(mx > DF_THR)) { const float dl = fmaxf(mx, 0.f), f = __builtin_amdgcn_exp2f(-dl); mref += dl; l *= f; skl *= f; \
                _Pragma("unroll") for (int db = 0; db < 4; ++db) _Pragma("unroll") for (int r = 0; r < 16; ++r) asm volatile("v_mul_f32 %0, %0, %1" : "+v"(o[db][r]) : "v"(f)); \
                _Pragma("unroll") for (int r = 0; r < 16; ++r) { sc0[r] -= dl; sc1[r] -= dl; } } } \
        D3_PV(vt, 0.f); } while (0)
#define D3_END_STEP(done_) do { if (lane == 0) flags[wave] = (done_) ? 1u : 0u; if (p >= 1) { knA = KN[m * 128 + 2 * p - 1]; knB = KN[m * 128 + 2 * p - 2]; } \
        asm volatile("s_waitcnt vmcnt(0) lgkmcnt(0)" ::: "memory");        \
        __builtin_amdgcn_s_barrier(); asm volatile("" ::: "memory"); unsigned f_ = 1u; _Pragma("unroll") for (int w_ = 0; w_ < 8; ++w_) f_ &= flags[w_]; alldone = f_ != 0u; } while (0)
    if (m) __builtin_amdgcn_s_setprio(1);
    int p = pmax; float knA = 0.f, knB = 0.f;
    {
        if (wq >= 2) { D3_DIAG(2 * p + 1); D3_NORMAL(2 * p, KN[m * 128 + 2 * p]); } else { D3_DIAG(2 * p); }
        D3_END_STEP(mydone); --p;
    }
    while (p >= 0 && !alldone) {
        if (p >= 1) D3_DMA_PAIR(p - 1);
        const float kn1 = knA, kn0 = knB;
        if (!mydone) { D3_NORMAL(2 * p + 1, kn1); }
        if (!mydone) { D3_NORMAL(2 * p, kn0); }
        D3_END_STEP(mydone); --p;
    }
    __builtin_amdgcn_s_setprio(0);
#undef D3_DMA_T
#undef D3_DMA_PAIR
#undef D3_KFRAG
#undef D3_VPRE
#undef D3_PV
#undef D3_DIAG
#undef D3_NORMAL
#undef D3_END_STEP
    asm volatile("s_waitcnt vmcnt(0) lgkmcnt(0)" ::: "memory");
    __syncthreads();
    l += __shfl_xor(l, 32);
    const float inv = 1.f / l;
    LAS float* X = (LAS float*)lds;
    if (m == 1) {
#pragma unroll
        for (int db = 0; db < 4; ++db)
#pragma unroll
            for (int r = 0; r < 16; ++r) X[((wq * 4 + db) * 16 + r) * 64 + lane] = o[db][r] * inv;
    }
    __syncthreads();
    if (m == 0) {
        float ss = 0.f;
#pragma unroll
        for (int db = 0; db < 4; ++db)
#pragma unroll
            for (int r = 0; r < 16; ++r) { const float av = o[db][r] * inv - lam * X[((wq * 4 + db) * 16 + r) * 64 + lane]; o[db][r] = av; ss += av * av; }
        ss += __shfl_xor(ss, 32);
        const float rs = rsqrtf(ss * (1.f / 128.f) + LN_EPS) * (1.f - LAMBDA_INIT1);
        bf16_t* op = mix + ((size_t)b * SEQ + trow) * D + h * 128;
#pragma unroll
        for (int db = 0; db < 4; ++db)
#pragma unroll
            for (int g = 0; g < 4; ++g) { const int e0 = db * 32 + 8 * g + 4 * hi; const f32x4 sg = *(const f32x4*)(subg + e0);
                v2u w; w.x = cvtpk(o[db][4 * g] * rs * sg.x, o[db][4 * g + 1] * rs * sg.y); w.y = cvtpk(o[db][4 * g + 2] * rs * sg.z, o[db][4 * g + 3] * rs * sg.w);
                *(GAS v2u*)(op + e0) = w; }
    }
    __syncthreads();
}
template <int PVAR> __device__ __forceinline__ void phase_diff(Frame& F, const Args& a) {
    const bf16_t* proj = (const bf16_t*)(a.ws + WS_BIG); bf16_t* mix = (bf16_t*)(a.ws + WS_MIX); const float* kn2 = (const float*)((const unsigned*)(a.ws + WS_CTL) + CW_KNA);
    float s1 = 0.f, s2 = 0.f;
    for (int i = 0; i < 64; ++i) { s1 += a.in[13][i] * a.in[14][i]; s2 += a.in[15][i] * a.in[16][i]; }
    const float lam = __expf(s1) - __expf(s2) + LAMBDA_INIT1;
    LAS int* qw = (LAS int*)(F.lds + D3_Q);
    gu32* heads = F.ctl + CW_QDIFF + (PVAR ? 1024 : 0);
    int q = (F.G % 8 == 0) ? (F.vcu / (F.G / 8)) : (int)(blockIdx.x & 7), tries = 0;
    for (;;) {
        if (F.tid == 0) qw[0] = (int)__hip_atomic_fetch_add(heads + 64 * q, 1u, RLX_AGENT);
        __syncthreads();
        const int k = qw[0];
        __syncthreads();
        if (k >= 256) { if (++tries >= 8) break; q = (q + 1) & 7; continue; }
        const int si = k >> 6, qb = 63 - (k & 63), b = q & 3;
        const int h = (q < 4) ? (si == 0 ? 7 : (si == 1 ? 4 : (si == 2 ? 3 : 0))) : (si == 0 ? 6 : (si == 1 ? 5 : (si == 2 ? 2 : 1)));
        diff_unit3<PVAR>(F, proj, mix, a.in[17], kn2, lam, b, h, qb);
    }
}
#ifndef PROBE_DIFFV
#define PROBE_DIFFV 0
#endif
#define PHASE_MIXA if constexpr (l == 0) phase_mixa0(F, a); else { if (PROBE_DIFFV > 0) phase_diff<PROBE_DIFFV>(F, a); phase_diff<0>(F, a); }
#define PHASE_SCAN phase_scan0(F, a);
#define PHASE_MIXB phase_mixb0(F, a);
#define PHASE_LNR phase_lnr(F, a, l, DRY);
#define PHASE_COMB phase_comb(F, a, l);
constexpr int NSLOTS = 22;
#ifndef PROBE_DUP
#define PROBE_DUP (-1)
#endif
#define REP(k) for (int rep_ = 0; rep_ < (((k) == PROBE_DUP) ? 2 : 1); ++rep_)
#define DRYK(k) (((k) == PROBE_DUP) && rep_ == 0)
#ifndef PROBE_OUTX
#define PROBE_OUTX 0
#endif
struct KArgs { const float* in[25]; float* out; unsigned char* ws; int ph_lo, ph_hi, li, pad; };

#define IN(k) (lo <= (k) && (k) < hi)
#if defined(PROBE_BAR2)
#define GRID_BAR(k) do { if ((k) + 1 < hi) { xcd_barrier(bar); xcd_barrier(bar); } } while (0)
#else
#define GRID_BAR(k) do { if ((k) + 1 < hi) xcd_barrier(bar); } while (0)
#endif
template <int l> __device__ __forceinline__ void layer_body(Frame& F, const Args& a, const int lo, const int hi, const XcdBarrier& bar) {
    unsigned char* ws = a.ws;
    bf16_t* U = (bf16_t*)(ws + WS_U); bf16_t* MIX = (bf16_t*)(ws + WS_MIX); bf16_t* PROJ = (bf16_t*)(ws + WS_BIG); bf16_t* XS = (bf16_t*)(ws + WS_XS); bf16_t* Hb = (bf16_t*)(ws + WS_H);
    const float* mod = (const float*)(ws + WS_MOD);
        const int base = 2 + 10 * l;
    if (IN(base + 0)) { REP(base + 0) {
        const int N = l ? ODD_IN : EVEN_IN;
        pg8::Gemm g{U, (const bf16_t*)(ws + (l ? WS_WIN1 : WS_WIN0)), T, N, D}; pg8::StaticOrder S; S.init(T, N, F.G, (int)blockIdx.x);
        if constexpr (l == 0) { pg8::EpiStoreBf16 E{PROJ, N, 0xffff}; pg8::gemm_phase<pg8::EpiStoreBf16, pg8::StaticOrder, true, true>(F.lds + RING_OFF, g, S, E); }
        else { pg8::EpiProj1 E{PROJ, N, (unsigned*)(ws + WS_CTL) + CW_KNA}; pg8::gemm_phase<pg8::EpiProj1, pg8::StaticOrder, true, true>(F.lds + RING_OFF, g, S, E); } }
        GRID_BAR(base + 0);
    }
    if (IN(base + 1)) { REP(base + 1) { PHASE_MIXA } bg_pump(F, a, l == 0 ? 2 : 3); GRID_BAR(base + 1); }
    if (l == 0) {
        if (IN(base + 2)) { PHASE_SCAN GRID_BAR(base + 2); }
        if (IN(base + 3)) { REP(base + 3) { PHASE_MIXB } GRID_BAR(base + 3); }
    }
    if (IN(base + 4)) { REP(base + 4) {
        pg8::Gemm g{MIX, (const bf16_t*)(ws + (l ? WS_WOUT1 : WS_WOUT0)), T, D, D}; pg8::StaticOrder S; S.init(T, D, F.G, (int)blockIdx.x);
        if constexpr (l == 0) { pg8::EpiOut<false> E{(bf16_t*)(ws + WS_Y), (const void*)a.in[0], mod + 2 * D, (float*)(ws + WS_STATS)};
            pg8::gemm_phase<pg8::EpiOut<false>, pg8::StaticOrder, true, true>(F.lds + RING_OFF, g, S, E); }
        else { pg8::EpiOut<true> E{(bf16_t*)(ws + WS_Y), (const void*)a.out, mod + (size_t)l * 4 * 6 * D + 2 * D, (float*)(ws + WS_STATS)};
            pg8::gemm_phase<pg8::EpiOut<true>, pg8::StaticOrder, true, true>(F.lds + RING_OFF, g, S, E); } }
        GRID_BAR(base + 4);
    }
    if (IN(base + 5)) { { const bool DRY = false; PHASE_LNR } if (l == 1) bg_pump(F, a, -1); GRID_BAR(base + 5); }
    if (IN(base + 7)) { REP(base + 7) {
        pg8::Gemm g{(const bf16_t*)ws, (const bf16_t*)(ws + WS_W13) + (size_t)l * NEXP * 1024 * 1024, PMAX, 1024, D}; LAS int* ttl = (LAS int*)(F.lds + TT_LDS_OFF); moe_tables(F, a, l, true, true);
        pg8::MoeOrder S; S.init(ttl, F.G, F.vcu);
        pg8::EpiMoe1 E{Hb};
        pg8::gemm_phase<pg8::EpiMoe1, pg8::MoeOrder, true, true, true>(F.lds + RING_OFF, g, S, E, (const LAS unsigned*)(F.lds + GOFF_LDS_OFF)); }
        if (l == 0) bg_pump(F, a, 0);
        GRID_BAR(base + 7);
    }
    if (IN(base + 8)) { REP(base + 8) {
        pg8::Gemm g{Hb, (const bf16_t*)(ws + WS_W2) + (size_t)l * NEXP * 1024 * 512, PMAX, 1024, FF}; LAS int* ttl = (LAS int*)(F.lds + TT_LDS_OFF); moe_tables(F, a, l, true, false);
        pg8::MoeOrder S; S.init(ttl, F.G, F.vcu);
        pg8::EpiStoreBf16 E{XS, D, 3};
        pg8::gemm_phase<pg8::EpiStoreBf16, pg8::MoeOrder, true, true>(F.lds + RING_OFF, g, S, E); }
        if (l == 0) bg_pump(F, a, 1);
        GRID_BAR(base + 8);
    }
    if (IN(base + 9)) { REP(base + 9) { PHASE_COMB } GRID_BAR(base + 9); }
}
#undef IN
#undef GRID_BAR

__global__ void __launch_bounds__(NWAVES * 64, 2) mega(KArgs args) {
    extern __shared__ __attribute__((aligned(16))) unsigned char lds[];
    Frame F;
    F.lds = (LAS unsigned char*)lds;
    F.MISC = (volatile LAS unsigned*)(F.lds + MISC_OFF);
    F.tid = threadIdx.x; F.lane = F.tid & 63; F.wave = __builtin_amdgcn_readfirstlane(F.tid >> 6);
    F.G = gridDim.x; { const int bx = blockIdx.x; F.vcu = (F.G % 8 == 0) ? (bx % 8) * (F.G / 8) + bx / 8 : bx; }
    unsigned char* ws = args.ws;
    F.ctl = (gu32*)(ws + WS_CTL);
    for (int u = F.tid; u < (LDS_BYTES - LDSCTL_OFF) / 4; u += NWAVES * 64) ((LAS unsigned*)(F.lds + LDSCTL_OFF))[u] = 0u;
    __syncthreads();
    const int lo = args.ph_lo, hi = args.ph_hi;
    XcdBarrier bar; bar.bar = (unsigned*)(F.ctl + CW_BAR) + args.li * XCD_BAR_WORDS; bar.x = 0; bar.st = nullptr;
    if (hi - lo > 1) bar = xcd_barrier_post((unsigned*)(F.ctl + CW_BAR) + args.li * XCD_BAR_WORDS, F.MISC + 8);
#define IN(k) (lo <= (k) && (k) < hi)
#define GRID_BAR(k) do { if ((k) + 1 < hi) xcd_barrier(bar); } while (0)

    Args a;
#pragma unroll
    for (int i = 0; i < 25; ++i) a.in[i] = args.in[i];
    a.out = args.out; a.ws = ws; a.ph_lo = lo; a.ph_hi = hi;

    if (IN(0)) { REP(0) { phase_pro_a(F, a); } GRID_BAR(0); }
    if (IN(1)) { REP(1) { phase_pro_b(F, a); } GRID_BAR(1); }

    layer_body<0>(F, a, lo, hi, bar);
    layer_body<1>(F, a, lo, hi, bar);
#if defined(PROBE_XBAR)
    for (int i_ = 0; i_ < PROBE_XBAR; ++i_) xcd_barrier(bar);
#endif
#undef IN
#undef GRID_BAR
}
#define HOST_PLAN \
    MEGA(0, 22);
static int g_grid = 0;
static void launch_mega(const KArgs& base, int lo, int hi, int& li, hipStream_t stream) {
    KArgs a = base; a.ph_lo = lo; a.ph_hi = hi; a.li = li++; a.pad = 0;
    hipLaunchKernelGGL(mega, dim3(g_grid), dim3(NWAVES * 64), LDS_BYTES, stream, a);
}
extern "C" void kernel_launch(void* const* d_in, const int* in_sizes, int n_in, void* d_out, int out_size, void* d_ws, size_t ws_size, hipStream_t stream) {
    if (n_in != 25 || out_size != T * D || ws_size < WS_END) { fprintf(stderr, "kernel_launch: unexpected sizes n_in %d out %d ws %zu (need %zu)\n", n_in, out_size, ws_size, (size_t)WS_END); return; }
    if (g_grid == 0) {
        int dev = 0, cus = 0;
        if (hipGetDevice(&dev) != hipSuccess || hipDeviceGetAttribute(&cus, hipDeviceAttributeMultiprocessorCount, dev) != hipSuccess) { g_grid = -1; return; }
        if (hipFuncSetAttribute((const void*)mega, hipFuncAttributeMaxDynamicSharedMemorySize, LDS_BYTES) != hipSuccess) { g_grid = -1; return; }
        int per_cu = 0; (void)hipOccupancyMaxActiveBlocksPerMultiprocessor(&per_cu, (const void*)mega, NWAVES * 64, LDS_BYTES); (void)hipGetLastError();
        g_grid = cus;
    }
    if (g_grid < 0) return;
    const float* x = (const float*)d_in[0];
    const float *ln1_g = (const float*)d_in[2], *ln1_b = (const float*)d_in[3], *ln2_g = (const float*)d_in[4], *ln2_b = (const float*)d_in[5];
    const float *ret_gn = (const float*)d_in[10];
    const float *lq1 = (const float*)d_in[13], *lk1 = (const float*)d_in[14], *lq2 = (const float*)d_in[15], *lk2 = (const float*)d_in[16], *subg = (const float*)d_in[17];
    const float *bgrp = (const float*)d_in[19], *brt = (const float*)d_in[21];
    unsigned char* ws = (unsigned char*)d_ws; float* out = (float*)d_out;
    unsigned* ctl = (unsigned*)(ws + WS_CTL); float* mod = (float*)(ws + WS_MOD); float* WrT = (float*)(ws + WS_WRT);
    bf16_t *U = (bf16_t*)(ws + WS_U), *MIX = (bf16_t*)(ws + WS_MIX), *PROJ = (bf16_t*)(ws + WS_BIG), *XS = (bf16_t*)(ws + WS_XS);
    int* tok_e = (int*)(ws + WS_ROUTE + RT_TOKE); float* tok_g = (float*)(ws + WS_ROUTE + RT_TOKG); int* tok_rank = (int*)(ws + WS_ROUTE + RT_RANK); int* tok_slot = (int*)(ws + WS_ROUTE + RT_SLOT); int* tile_tab = (int*)(ws + WS_ROUTE + RT_TILE);
    (void)hipMemsetAsync(ws + WS_CTL, 0, CTL_ZERO_BYTES, stream);
    KArgs ka{}; for (int i = 0; i < 25; ++i) ka.in[i] = (const float*)d_in[i]; ka.out = out; ka.ws = ws;
    int li = 0;
#define MEGA(lo, hi) launch_mega(ka, lo, hi, li, stream)
    HOST_PLAN
#undef MEGA
}
```
